# Optimizing an MI355X kernel written in HIP

```python
import jax, jax.numpy as jnp
from jax import lax
import numpy as np

D_MODEL = 2048
BATCH = 2
SEQ = 8192
DEPTH = 2

HEAD_DIM = 128
ROT_DIM = HEAD_DIM // 4
ROPE_THETA = 500000.0
NORM_EPS = 1e-6
D_FF = 4 * D_MODEL
D_PLE = 256
N_A_LAYERS = DEPTH // 2
N_B_LAYERS = DEPTH - N_A_LAYERS
QBLOCK = 128
NEG_INF = -1e30
FORCE_SCORE = 1e9
TINY = 1e-20

DILATED_GROUPS = ((128, 1), (512, 4), (2048, 16))
HEADS_PER_GROUP_A = D_MODEL // (2 * HEAD_DIM)

NSA_HEADS = D_MODEL // HEAD_DIM
NSA_KV_GROUPS = 4
CMP_LEN = 32
CMP_STRIDE = 16
CMP_HIDDEN = 2 * HEAD_DIM
SLC_LEN = 64
SLC_TOP_N = 16
WIN_LEN = 512
N_NSA_BRANCH = 3

kernel_name = "yoco_dilated_nsa_hybrid"


def rmsnorm(x, g):
    xf = x.astype(jnp.float32)
    y = xf * lax.rsqrt(jnp.mean(xf * xf, axis=-1, keepdims=True) + NORM_EPS)
    return (y * g.astype(jnp.float32)).astype(x.dtype)


def rope_partial(x, pos):
    half = ROT_DIM // 2
    inv = ROPE_THETA ** (-jnp.arange(half, dtype=jnp.float32) * (2.0 / ROT_DIM))
    ang = pos.astype(jnp.float32)[:, None] * inv[None, :]
    cos = jnp.cos(ang)[:, None, :]
    sin = jnp.sin(ang)[:, None, :]
    xf = x.astype(jnp.float32)
    x1 = xf[..., :half]
    x2 = xf[..., half:ROT_DIM]
    out = jnp.concatenate([x1 * cos - x2 * sin, x2 * cos + x1 * sin, xf[..., ROT_DIM:]], axis=-1)
    return out.astype(x.dtype)


def dilated_mixture_attention(xn, w_in, w_out):
    B, S, _ = xn.shape
    G, Hg, dh = len(DILATED_GROUPS), HEADS_PER_GROUP_A, HEAD_DIM
    nb = S // QBLOCK
    pos = jnp.arange(S)
    qkv = (xn @ w_in).reshape(B, S, 3, G * Hg, dh)
    q = (rope_partial(qkv[:, :, 0], pos) * (dh ** -0.5)).reshape(B, S, G, Hg, dh)
    k = rope_partial(qkv[:, :, 1], pos).reshape(B, S, G, Hg, dh)
    v = qkv[:, :, 2].reshape(B, S, G, Hg, dh)
    q_blocks = q.reshape(B, nb, QBLOCK, G, Hg, dh).transpose(1, 0, 2, 3, 4, 5)

    def block(args):
        bi, qb = args
        t = bi * QBLOCK + jnp.arange(QBLOCK)
        outs, lses = [], []
        for g, (window, dil) in enumerate(DILATED_GROUPS):
            n_keys = window // dil + 1
            idx = t[:, None] - dil * jnp.arange(n_keys)[None, :]
            valid = idx >= 0
            idx = jnp.maximum(idx, 0)
            kg = jnp.take(k[:, :, g], idx, axis=1)
            vg = jnp.take(v[:, :, g], idx, axis=1)
            s = jnp.einsum('bqhd,bqnhd->bhqn', qb[:, :, g], kg, preferred_element_type=jnp.float32)
            s = jnp.where(valid[None, None], s, NEG_INF)
            lse = jax.nn.logsumexp(s, axis=-1)
            pr = jnp.exp(s - lse[..., None])
            outs.append(jnp.einsum('bhqn,bqnhd->bqhd', pr.astype(vg.dtype), vg).astype(jnp.float32))
            lses.append(lse)
        wts = jax.nn.softmax(jnp.stack(lses), axis=0)
        wts = wts.transpose(0, 1, 3, 2)[..., None]
        o = jnp.sum(wts * jnp.stack(outs), axis=0)
        return o.reshape(B, QBLOCK, Hg * dh).astype(xn.dtype)

    o = lax.map(block, (jnp.arange(nb), q_blocks))
    o = o.transpose(1, 0, 2, 3).reshape(B, S, Hg * dh)
    return o @ w_out


def compress_blocks(blocks, pe, w1, w2):
    B, n, L, G, dh = blocks.shape
    z = (blocks + pe[None, None, :, None, :]).transpose(0, 1, 3, 2, 4).reshape(B, n, G, L * dh)
    return jax.nn.gelu(z @ w1) @ w2


def nsa_shared_kv(hn, w_kv, cmp_pe_k, cmp_w1_k, cmp_w2_k, cmp_pe_v, cmp_w1_v, cmp_w2_v):
    B, S, _ = hn.shape
    G, dh = NSA_KV_GROUPS, HEAD_DIM
    pos = jnp.arange(S)
    kv = (hn @ w_kv).reshape(B, S, 6, G, dh)
    k_cmp_raw, v_cmp_raw = kv[:, :, 0], kv[:, :, 1]
    k_slc = rope_partial(kv[:, :, 2], pos)
    v_slc = kv[:, :, 3]
    k_win = rope_partial(kv[:, :, 4], pos)
    v_win = kv[:, :, 5]
    n_cmp = (S - CMP_LEN) // CMP_STRIDE + 1
    starts = jnp.arange(n_cmp) * CMP_STRIDE
    idx = starts[:, None] + jnp.arange(CMP_LEN)[None, :]
    k_cmp = compress_blocks(jnp.take(k_cmp_raw, idx, axis=1), cmp_pe_k, cmp_w1_k, cmp_w2_k)
    k_cmp = rope_partial(k_cmp, starts + CMP_LEN - 1)
    v_cmp = compress_blocks(jnp.take(v_cmp_raw, idx, axis=1), cmp_pe_v, cmp_w1_v, cmp_w2_v)
    n_slc = S // SLC_LEN
    k_slc_b = k_slc.reshape(B, n_slc, SLC_LEN, G, dh).transpose(0, 3, 1, 2, 4)
    v_slc_b = v_slc.reshape(B, n_slc, SLC_LEN, G, dh).transpose(0, 3, 1, 2, 4)
    pad = ((0, 0), (WIN_LEN, 0), (0, 0), (0, 0))
    return (k_cmp, v_cmp, k_slc_b, v_slc_b, jnp.pad(k_win, pad), jnp.pad(v_win, pad))


def nsa_attention(xn, w_qg, w_out, k_cmp, v_cmp, k_slc_b, v_slc_b, k_win_pad, v_win_pad):
    B, S, _ = xn.shape
    H, G, dh = NSA_HEADS, NSA_KV_GROUPS, HEAD_DIM
    hpg = H // G
    nb = S // QBLOCK
    n_cmp = k_cmp.shape[1]
    n_slc = k_slc_b.shape[2]
    top_n = min(SLC_TOP_N, n_slc)
    pos = jnp.arange(S)
    qg = xn @ w_qg
    q = (rope_partial(qg[..., :H * dh].reshape(B, S, H, dh), pos) * (dh ** -0.5)).reshape(B, S, G, hpg, dh)
    gates = jax.nn.sigmoid(qg[..., H * dh:].astype(jnp.float32)).reshape(B, S, N_NSA_BRANCH, G, hpg)
    q_blocks = q.reshape(B, nb, QBLOCK, G, hpg, dh).transpose(1, 0, 2, 3, 4, 5)
    g_blocks = gates.reshape(B, nb, QBLOCK, N_NSA_BRANCH, G, hpg).transpose(1, 0, 2, 3, 4, 5)

    cmp_start = jnp.arange(n_cmp) * CMP_STRIDE
    cmp_end = cmp_start + CMP_LEN - 1
    slc_start = jnp.arange(n_slc) * SLC_LEN
    overlap = jnp.clip(jnp.minimum(cmp_start[:, None] + CMP_LEN, slc_start[None, :] + SLC_LEN)
                       - jnp.maximum(cmp_start[:, None], slc_start[None, :]), 0, None)
    overlap = overlap.astype(jnp.float32) / CMP_LEN
    bix = jnp.arange(B)[:, None, None, None]
    gix = jnp.arange(G)[None, None, :, None]

    def block(args):
        bi, qb, gb = args
        t = bi * QBLOCK + jnp.arange(QBLOCK)
        s_c = jnp.einsum('bqghd,bcgd->bqghc', qb, k_cmp, preferred_element_type=jnp.float32)
        vc = (cmp_end[None, :] <= t[:, None])[None, :, None, None, :]
        s_c = jnp.where(vc, s_c, NEG_INF)
        e = jnp.where(vc, jnp.exp(s_c - jnp.max(s_c, axis=-1, keepdims=True)), 0.0)
        p_c = e / jnp.maximum(jnp.sum(e, axis=-1, keepdims=True), TINY)
        o_cmp = jnp.einsum('bqghc,bcgd->bqghd', p_c.astype(v_cmp.dtype), v_cmp).astype(jnp.float32)
        imp = jnp.einsum('bqghc,cj->bqgj', p_c, overlap)
        jidx = jnp.arange(n_slc)[None, :]
        cur = (t // SLC_LEN)[:, None]
        forced = ((jidx == 0) | (jidx == cur) | (jidx == cur - 1))[None, :, None, :]
        causal = (jidx * SLC_LEN <= t[:, None])[None, :, None, :]
        score = jnp.where(forced, FORCE_SCORE, jnp.where(causal, imp, NEG_INF))
        _, sel = lax.top_k(score, top_n)
        ks = k_slc_b[bix, gix, sel]
        vs = v_slc_b[bix, gix, sel].reshape(B, QBLOCK, G, top_n * SLC_LEN, dh)
        tok = sel[..., None] * SLC_LEN + jnp.arange(SLC_LEN)
        vsm = (tok <= t[None, :, None, None, None]).reshape(B, QBLOCK, G, 1, top_n * SLC_LEN)
        s_s = jnp.einsum('bqghd,bqgnld->bqghnl', qb, ks, preferred_element_type=jnp.float32)
        s_s = jnp.where(vsm, s_s.reshape(B, QBLOCK, G, hpg, top_n * SLC_LEN), NEG_INF)
        p_s = jax.nn.softmax(s_s, axis=-1)
        o_slc = jnp.einsum('bqghk,bqgkd->bqghd', p_s.astype(vs.dtype), vs).astype(jnp.float32)
        t0 = bi * QBLOCK
        kw = lax.dynamic_slice_in_dim(k_win_pad, t0, WIN_LEN + QBLOCK, axis=1)
        vw = lax.dynamic_slice_in_dim(v_win_pad, t0, WIN_LEN + QBLOCK, axis=1)
        kp = t0 - WIN_LEN + jnp.arange(WIN_LEN + QBLOCK)
        dist = t[:, None] - kp[None, :]
        vwm = ((dist >= 0) & (dist < WIN_LEN) & (kp[None, :] >= 0))[None, :, None, None, :]
        s_w = jnp.einsum('bqghd,bkgd->bqghk', qb, kw, preferred_element_type=jnp.float32)
        p_w = jax.nn.softmax(jnp.where(vwm, s_w, NEG_INF), axis=-1)
        o_win = jnp.einsum('bqghk,bkgd->bqghd', p_w.astype(vw.dtype), vw).astype(jnp.float32)
        o = (gb[:, :, 0, ..., None] * o_cmp + gb[:, :, 1, ..., None] * o_slc
             + gb[:, :, 2, ..., None] * o_win)
        return o.reshape(B, QBLOCK, H * dh).astype(xn.dtype)

    o = lax.map(block, (jnp.arange(nb), q_blocks, g_blocks))
    o = o.transpose(1, 0, 2, 3).reshape(B, S, H * dh)
    return o @ w_out


def setup_inputs(seed: int = 0) -> dict:
    key = jax.random.key(seed)
    ks = jax.random.split(key, 24)
    f32 = jnp.float32

    def nrm(k, shape, fan_in, scale=1.0):
        return jax.random.normal(k, shape, f32) * (scale * fan_in ** -0.5)

    def gain(k, shape):
        return 1.0 + 0.02 * jax.random.normal(k, shape, f32)

    GA = len(DILATED_GROUPS)
    a_in_cols = 3 * GA * HEADS_PER_GROUP_A * HEAD_DIM
    a_out_rows = HEADS_PER_GROUP_A * HEAD_DIM
    b_q_cols = NSA_HEADS * HEAD_DIM + N_NSA_BRANCH * NSA_HEADS
    kv_cols = 6 * NSA_KV_GROUPS * HEAD_DIM
    return {
        "x": jax.random.normal(ks[0], (BATCH, SEQ, D_MODEL), f32),
        "p": jax.random.normal(ks[1], (DEPTH, BATCH, SEQ, D_PLE), f32),
        "a_w_in": nrm(ks[2], (N_A_LAYERS, D_MODEL, a_in_cols), D_MODEL),
        "a_w_out": nrm(ks[3], (N_A_LAYERS, a_out_rows, D_MODEL), a_out_rows),
        "b_w_qg": nrm(ks[4], (N_B_LAYERS, D_MODEL, b_q_cols), D_MODEL),
        "b_w_out": nrm(ks[5], (N_B_LAYERS, NSA_HEADS * HEAD_DIM, D_MODEL), NSA_HEADS * HEAD_DIM),
        "kv_norm_g": gain(ks[6], (D_MODEL,)),
        "w_kv_shared": nrm(ks[7], (D_MODEL, kv_cols), D_MODEL),
        "cmp_pe_k": 0.1 * jax.random.normal(ks[8], (CMP_LEN, HEAD_DIM), f32),
        "cmp_w1_k": nrm(ks[9], (CMP_LEN * HEAD_DIM, CMP_HIDDEN), CMP_LEN * HEAD_DIM),
        "cmp_w2_k": nrm(ks[10], (CMP_HIDDEN, HEAD_DIM), CMP_HIDDEN, 2.0),
        "cmp_pe_v": 0.1 * jax.random.normal(ks[11], (CMP_LEN, HEAD_DIM), f32),
        "cmp_w1_v": nrm(ks[12], (CMP_LEN * HEAD_DIM, CMP_HIDDEN), CMP_LEN * HEAD_DIM),
        "cmp_w2_v": nrm(ks[13], (CMP_HIDDEN, HEAD_DIM), CMP_HIDDEN, 2.0),
        "attn_norm_g": gain(ks[14], (DEPTH, D_MODEL)),
        "mlp_norm_g": gain(ks[15], (DEPTH, D_MODEL)),
        "mlp_w1": nrm(ks[16], (DEPTH, D_MODEL, D_FF), D_MODEL),
        "mlp_w2": nrm(ks[17], (DEPTH, D_FF, D_MODEL), D_FF, 0.5),
        "ple_norm_g": gain(ks[18], (DEPTH, D_MODEL)),
        "ple_w_gate": nrm(ks[19], (DEPTH, D_MODEL, D_MODEL), D_MODEL),
        "ple_w_proj": nrm(ks[20], (DEPTH, D_PLE, D_MODEL), D_PLE, 0.5),
        "final_norm_g": gain(ks[21], (D_MODEL,)),
    }


def reference(x, p, a_w_in, a_w_out, b_w_qg, b_w_out, kv_norm_g, w_kv_shared,
              cmp_pe_k, cmp_w1_k, cmp_w2_k, cmp_pe_v, cmp_w1_v, cmp_w2_v,
              attn_norm_g, mlp_norm_g, mlp_w1, mlp_w2, ple_norm_g, ple_w_gate, ple_w_proj,
              final_norm_g):
    h = x
    shared = None
    for i in range(DEPTH):
        hn = rmsnorm(h, attn_norm_g[i])
        if i < N_A_LAYERS:
            h = h + dilated_mixture_attention(hn, a_w_in[i], a_w_out[i])
        else:
            if i == N_A_LAYERS:
                shared = nsa_shared_kv(rmsnorm(h, kv_norm_g), w_kv_shared,
                                       cmp_pe_k, cmp_w1_k, cmp_w2_k, cmp_pe_v, cmp_w1_v, cmp_w2_v)
            j = i - N_A_LAYERS
            h = h + nsa_attention(hn, b_w_qg[j], b_w_out[j], *shared)
        hn = rmsnorm(h, mlp_norm_g[i])
        h = h + jnp.square(jax.nn.relu(hn @ mlp_w1[i])) @ mlp_w2[i]
        gate = jax.nn.sigmoid(rmsnorm(h, ple_norm_g[i]) @ ple_w_gate[i])
        h = h + (p[i] @ ple_w_proj[i]) * gate
    return rmsnorm(h, final_norm_g)
```

```cpp
#include <hip/hip_runtime.h>
#include <hip/hip_cooperative_groups.h>
#include <cstdio>
#include <cmath>
namespace cg = cooperative_groups;

#define LAS __attribute__((address_space(3)))
#define DI __device__ __forceinline__
typedef unsigned short bf16_t;
typedef short bf16x8 __attribute__((ext_vector_type(8)));
typedef short s16x4 __attribute__((ext_vector_type(4)));
typedef float f32x4 __attribute__((ext_vector_type(4)));
typedef float f32x2 __attribute__((ext_vector_type(2)));
typedef unsigned u32x4 __attribute__((ext_vector_type(4)));
typedef unsigned u32x2 __attribute__((ext_vector_type(2)));
typedef __bf16 bfv2 __attribute__((ext_vector_type(2)));

constexpr int T = 16384, SEQ = 8192, DM = 2048;
constexpr float EPS = 1e-6f;
constexpr float QSCALE = 0.08838834764831845f * 1.4426950408889634f;
constexpr float NEGBIG = -1e30f;
constexpr float M_INIT = -30000.0f;

DI unsigned pk_bf16(float a, float b) { f32x2 v = {a, b}; bfv2 r = __builtin_convertvector(v, bfv2); return __builtin_bit_cast(unsigned, r); }
DI float bf_lo(unsigned w) { return __uint_as_float(w << 16); }
DI float bf_hi(unsigned w) { return __uint_as_float(w & 0xffff0000u); }
DI float rstd_of(const float* sumsq, int row) { return rsqrtf(sumsq[row] * (1.0f / 2048.0f) + EPS); }
DI float sigmoidf(float x) { return 1.0f / (1.0f + __expf(-x)); }
DI float xrow_max(float t) {
    { const unsigned u = __float_as_uint(t); const auto r = __builtin_amdgcn_permlane16_swap(u, u, false, false); t = fmaxf(__uint_as_float(r[0]), __uint_as_float(r[1])); }
    { const unsigned u = __float_as_uint(t); const auto r = __builtin_amdgcn_permlane32_swap(u, u, false, false); t = fmaxf(__uint_as_float(r[0]), __uint_as_float(r[1])); }
    return t;
}
DI float xrow_sum(float t) {
    { const unsigned u = __float_as_uint(t); const auto r = __builtin_amdgcn_permlane16_swap(u, u, false, false); t = __uint_as_float(r[0]) + __uint_as_float(r[1]); }
    { const unsigned u = __float_as_uint(t); const auto r = __builtin_amdgcn_permlane32_swap(u, u, false, false); t = __uint_as_float(r[0]) + __uint_as_float(r[1]); }
    return t;
}

constexpr size_t WS_W_IN   = 0;
constexpr size_t WS_W_OUT  = WS_W_IN   + 37748736;
constexpr size_t WS_W_MLP1 = WS_W_OUT  + 4194304;
constexpr size_t WS_W_MLP2 = WS_W_MLP1 + 33554432;
constexpr size_t WS_W_GATE = WS_W_MLP2 + 33554432;
constexpr size_t WS_W_PROJ = WS_W_GATE + 8388608;
constexpr size_t WS_HB     = WS_W_PROJ + 1048576;
constexpr size_t WS_PB     = WS_HB     + 67108864;
constexpr size_t WS_R      = WS_PB     + 16777216;
constexpr size_t WS_OG     = WS_R      + 301989888;
constexpr size_t WS_SUMSQ  = WS_OG     + 100663296;
constexpr size_t WS_ROPE   = WS_SUMSQ  + 7 * 65536;
constexpr size_t WS_LSE    = WS_ROPE   + 1048576;
constexpr size_t WS_CPART  = WS_LSE    + 1572864;
constexpr size_t WS_END    = WS_CPART  + 65536;
constexpr size_t WS_BAR    = WS_END;
constexpr size_t WS_SEL    = WS_LSE;
constexpr size_t W1_KVQG = WS_W_IN, W1_BOUT = W1_KVQG + 22020096, W1_C1K = W1_BOUT + 8388608, W1_C1V = W1_C1K + 2097152, W1_C2K = W1_C1V + 2097152, W1_C2V = W1_C2K + 65536;
constexpr size_t KVSEC = 16777216;
constexpr size_t R_KV = WS_R, R_Q1 = WS_R + 6 * KVSEC, R_GATES = R_Q1 + 67108864, R_PQK = R_GATES + 3145728, R_PQV = R_PQK + 8388608, R_KCMP = R_PQV + 8388608, R_VCMP = R_KCMP + 1048576, R_O1 = R_VCMP + 1048576;

struct Args { const float* in[22]; float* out; unsigned char* ws; float inv_freq[16]; };

namespace pg8 {
#define PG8_LAS __attribute__((address_space(3)))
typedef unsigned short bf16_t;
typedef short bf16x8 __attribute__((ext_vector_type(8)));
typedef float f32x4 __attribute__((ext_vector_type(4)));
typedef unsigned u32x4 __attribute__((ext_vector_type(4)));
constexpr int BM = 256, BK = 64, HALF = 128, HTB = HALF * BK * 2  , STAGE_BYTES = 8 * HTB, NXCD = 8, WGM = 4;

__host__ __device__ __forceinline__ int lds_byte(int r, int c) { const int st = (r >> 4) * 2 + (c >> 5), rr = r & 15, cc = c & 31, ob = rr * 64 + cc * 2; return st * 1024 + (ob ^ (((ob >> 9) & 1) << 5)); }
__host__ __device__ __forceinline__ void stage_rc(int b, int& R, int& C) { const int st = b / 1024, sb = b % 1024, swz = sb ^ (((sb >> 9) & 1) << 5); R = (st >> 1) * 16 + swz / 64; C = (st & 1) * 32 + (swz % 64) / 2; }
__host__ __device__ __forceinline__ int perm32(int rho) { const int n = rho >> 4, i = rho & 15; return 8 * (i >> 2) + 4 * n + (i & 3); }

struct Unit { int pm, pn; };
struct Gemm { const bf16_t* A; const bf16_t* Bt; int M, N, K; };

struct StaticOrder {
    int nM, nN, nwg, G, c;
    __host__ __device__ void init(int M, int N, int G_, int c_) { nM = M / BM; nN = N / BM; nwg = nM * nN; G = G_; c = c_; }
    __host__ __device__ bool next(int i, Unit& u) const {
        const long L = (long)i * G + c; if (L >= nwg) return false;
        int wgid = (int)L; { const int q = nwg / NXCD, r = nwg % NXCD, xcd = wgid % NXCD, off = wgid / NXCD; wgid = (xcd < r ? xcd * (q + 1) : r * (q + 1) + (xcd - r) * q) + off; }
        const int nig = WGM * nN, gid = wgid / nig, fm = gid * WGM, gsz = (nM - fm) < WGM ? (nM - fm) : WGM;
        u.pm = fm + ((wgid % nig) % gsz); u.pn = (wgid % nig) / gsz; return true;
    }
    __device__ __forceinline__ void a_ready(const Unit&) const {}
    __device__ __forceinline__ void done(const Unit&) const {}
};

template <class Epi, class Sched>
__device__ __forceinline__ void gemm_phase(PG8_LAS unsigned char* lds, const Gemm g, const Sched& S, const Epi& E) {
    int tid = threadIdx.x; asm volatile("" : "+v"(tid));
    const int wid = __builtin_amdgcn_readfirstlane(tid >> 6), lane = tid & 63, wr = wid >> 2, wc = wid & 3, fr = lane & 15, fq = lane >> 4;
    const int K = g.K, nt = K / BK;
    unsigned voffA[2], voffB[2];
#pragma unroll
    for (int i = 0; i < 2; ++i) { int R, C; stage_rc(tid * 16 + i * 8192, R, C); const int Rb = Epi::PERM ? ((R & ~31) + perm32(R & 31)) : R;
        voffA[i] = (unsigned)(R * K + C) * 2u; voffB[i] = (unsigned)(Rb * K + C) * 2u; }
    const size_t kstep = (size_t)(BK * 2);
    const size_t hstep = (size_t)HALF * K * 2;
    const size_t tstep = 2 * hstep;
    const unsigned ldsw = (unsigned)wid * 1024u;
    const int aoff = lds_byte(wr * 64 + fr, fq * 8), boff = lds_byte(wc * 32 + fr, fq * 8);
#define PG8_SA(b, h) (((b) * 2 + (h)) * HTB)
#define PG8_SB(b, h) ((4 + (b) * 2 + (h)) * HTB)
#define PG8_STAGE(bufoff, gbase, voff) do { _Pragma("unroll") for (int _i = 0; _i < 2; ++_i) \
        __builtin_amdgcn_global_load_lds((const unsigned*)((const char*)(gbase) + (voff)[_i]), (PG8_LAS unsigned*)(lds + (bufoff) + ldsw + _i * 8192), 16, 0, 0); } while (0)
#define PG8_LDA(dst, b, h) do { _Pragma("unroll") for (int m = 0; m < 4; ++m) _Pragma("unroll") for (int k = 0; k < 2; ++k) dst[m][k] = *(const PG8_LAS bf16x8*)(lds + PG8_SA(b, h) + aoff + m * 2048 + k * 1024); } while (0)
#define PG8_LDB(dst, b, h) do { _Pragma("unroll") for (int n = 0; n < 2; ++n) _Pragma("unroll") for (int k = 0; k < 2; ++k) dst[n][k] = *(const PG8_LAS bf16x8*)(lds + PG8_SB(b, h) + boff + n * 2048 + k * 1024); } while (0)
#define PG8_MMA(ai, bj, At, Bt) do { __builtin_amdgcn_s_setprio(1); _Pragma("unroll") for (int m = 0; m < 4; ++m) _Pragma("unroll") for (int n = 0; n < 2; ++n) _Pragma("unroll") for (int k = 0; k < 2; ++k) \
        acc[ai][bj][m][n] = __builtin_amdgcn_mfma_f32_16x16x32_bf16(Bt[n][k], At[m][k], acc[ai][bj][m][n], 0, 0, 0); __builtin_amdgcn_s_setprio(0); } while (0)
#define PG8_WAIT_V(n) asm volatile("s_waitcnt vmcnt(" #n ")" ::: "memory")
#define PG8_WAIT_L(n) asm volatile("s_waitcnt lgkmcnt(" #n ")" ::: "memory")
#define PG8_BAR __builtin_amdgcn_s_barrier()
#define PG8_SCHED __builtin_amdgcn_sched_barrier(0)
    Unit cur, nxt; int ui = 0;
    if (!S.next(0, cur)) return;
    f32x4 acc[2][2][4][2];
#pragma unroll
    for (int a = 0; a < 2; ++a)
#pragma unroll
        for (int b = 0; b < 2; ++b)
#pragma unroll
            for (int m = 0; m < 4; ++m)
#pragma unroll
                for (int n = 0; n < 2; ++n) acc[a][b][m][n] = (f32x4){0.f, 0.f, 0.f, 0.f};
    bf16x8 At[4][2], B0[2][2], B1[2][2];
    const char* cA = (const char*)g.A + (size_t)cur.pm * tstep; const char* cB = (const char*)g.Bt + (size_t)cur.pn * tstep;
    S.a_ready(cur);
    PG8_STAGE(PG8_SB(0, 0), cB, voffB); PG8_STAGE(PG8_SA(0, 0), cA, voffA); PG8_STAGE(PG8_SB(0, 1), cB + hstep, voffB); PG8_STAGE(PG8_SA(0, 1), cA + hstep, voffA);
    if (wr == 1) PG8_BAR;
    PG8_WAIT_V(4); PG8_BAR;
    PG8_STAGE(PG8_SB(1, 0), cB + kstep, voffB); PG8_STAGE(PG8_SA(1, 0), cA + kstep, voffA); PG8_STAGE(PG8_SB(1, 1), cB + hstep + kstep, voffB);
    PG8_WAIT_V(6); PG8_BAR;
    for (;;) {
        const bool has_next = S.next(ui + 1, nxt);
        const char* nA = has_next ? (const char*)g.A + (size_t)nxt.pm * tstep : cA; const char* nB = has_next ? (const char*)g.Bt + (size_t)nxt.pn * tstep : cB;
        for (int t = 0; t < nt; t += 2) {
            const bool last = (t == nt - 2);
            const char* a1 = cA + (size_t)(t + 1) * kstep;
            const char* a2 = last ? nA : cA + (size_t)(t + 2) * kstep; const char* b2 = last ? nB : cB + (size_t)(t + 2) * kstep;
            const char* a3 = a2 + kstep; const char* b3 = b2 + kstep;
            if (last && has_next) S.a_ready(nxt);
            PG8_LDB(B0, 0, 0); PG8_SCHED; PG8_LDA(At, 0, 0); PG8_STAGE(PG8_SA(1, 1), a1 + hstep, voffA);
            PG8_WAIT_L(8); PG8_BAR; PG8_WAIT_L(0); PG8_MMA(0, 0, At, B0); PG8_BAR; PG8_SCHED;
            PG8_LDB(B1, 0, 1); PG8_STAGE(PG8_SB(0, 0), b2, voffB);
            PG8_BAR; PG8_WAIT_L(0); PG8_MMA(0, 1, At, B1); PG8_BAR;
            PG8_LDA(At, 0, 1); PG8_STAGE(PG8_SA(0, 0), a2, voffA);
            PG8_BAR; PG8_WAIT_L(0); PG8_MMA(1, 0, At, B0); PG8_BAR; PG8_SCHED;
            PG8_STAGE(PG8_SB(0, 1), b2 + hstep, voffB);
            PG8_WAIT_V(6); PG8_BAR; PG8_MMA(1, 1, At, B1); PG8_BAR;
            PG8_LDB(B0, 1, 0); PG8_SCHED; PG8_LDA(At, 1, 0); PG8_STAGE(PG8_SA(0, 1), a2 + hstep, voffA);
            PG8_WAIT_L(8); PG8_BAR; PG8_WAIT_L(0); PG8_MMA(0, 0, At, B0); PG8_BAR; PG8_SCHED;
            PG8_LDB(B1, 1, 1); PG8_STAGE(PG8_SB(1, 0), b3, voffB);
            PG8_BAR; PG8_WAIT_L(0); PG8_MMA(0, 1, At, B1); PG8_BAR;
            PG8_LDA(At, 1, 1); PG8_STAGE(PG8_SA(1, 0), a3, voffA);
            PG8_BAR; PG8_WAIT_L(0); PG8_MMA(1, 0, At, B0); PG8_BAR; PG8_SCHED;
            PG8_STAGE(PG8_SB(1, 1), b3 + hstep, voffB);
            PG8_WAIT_V(6); PG8_BAR; PG8_MMA(1, 1, At, B1); PG8_BAR;
        }
        if constexpr (!Epi::AFTER_DRAIN) { E(acc, cur, wr, wc, fr, fq); S.done(cur); }
        if (!has_next) break;
#pragma unroll
        for (int a = 0; a < 2; ++a)
#pragma unroll
            for (int b = 0; b < 2; ++b)
#pragma unroll
                for (int m = 0; m < 4; ++m)
#pragma unroll
                    for (int n = 0; n < 2; ++n) acc[a][b][m][n] = (f32x4){0.f, 0.f, 0.f, 0.f};
        cur = nxt; cA = nA; cB = nB; ++ui;
    }
    PG8_WAIT_V(0);
    if (wr == 0) PG8_BAR;
    PG8_BAR;
    if constexpr (Epi::AFTER_DRAIN) { E.fused(acc, cur, wr, wc, fr, fq, lds, wid, lane); S.done(cur); }
#undef PG8_SA
#undef PG8_SB
#undef PG8_STAGE
#undef PG8_LDA
#undef PG8_LDB
#undef PG8_MMA
#undef PG8_WAIT_V
#undef PG8_WAIT_L
#undef PG8_BAR
#undef PG8_SCHED
}
}

using pg8::Unit;
DI void rope4(f32x4& v0, f32x4& v1, const f32x4 cs0, const f32x4 cs1) {
    const float c[4] = {cs0[0], cs0[2], cs1[0], cs1[2]}, s[4] = {cs0[1], cs0[3], cs1[1], cs1[3]};
#pragma unroll
    for (int j = 0; j < 4; ++j) { const float x1 = v0[j], x2 = v1[j]; v0[j] = x1 * c[j] - x2 * s[j]; v1[j] = x2 * c[j] + x1 * s[j]; }
}
DI void st_bf4(bf16_t* p, const f32x4 v) { u32x2 w; w.x = pk_bf16(v[0], v[1]); w.y = pk_bf16(v[2], v[3]); *(u32x2*)p = w; }

DI void rstd8(float (&rs)[2][4], const float* sumsq, const Unit& u, int wr, int fr) {
#pragma unroll
    for (int ai = 0; ai < 2; ++ai)
#pragma unroll
        for (int m = 0; m < 4; ++m) rs[ai][m] = sumsq[u.pm * 256 + ai * 128 + wr * 64 + m * 16 + fr];
#pragma unroll
    for (int ai = 0; ai < 2; ++ai)
#pragma unroll
        for (int m = 0; m < 4; ++m) rs[ai][m] = rsqrtf(rs[ai][m] * (1.0f / 2048.0f) + EPS);
}
struct EpiQKV0 {
    static constexpr bool PERM = false, AFTER_DRAIN = false;
    bf16_t* out; const float* sumsq; const float* rope;
    DI void operator()(const f32x4 (&acc)[2][2][4][2], const Unit& u, int wr, int wc, int fr, int fq) const {
        float rsv[2][4]; rstd8(rsv, sumsq, u, wr, fr);
#pragma unroll
        for (int ai = 0; ai < 2; ++ai)
#pragma unroll
            for (int m = 0; m < 4; ++m) {
                const int row = u.pm * 256 + ai * 128 + wr * 64 + m * 16 + fr; const float rs = rsv[ai][m]; const int pos = row & (SEQ - 1);
                f32x4 cs0 = {1.f, 0.f, 1.f, 0.f}, cs1 = {1.f, 0.f, 1.f, 0.f};
                if (wc == 0) { const f32x4* rp = (const f32x4*)(rope + ((size_t)pos * 16 + 4 * fq) * 2); cs0 = rp[0]; cs1 = rp[1]; }
#pragma unroll
                for (int bj = 0; bj < 2; ++bj) {
                    const int colbase = u.pn * 256 + bj * 128; const int sect = colbase / 3072;
                    f32x4 v0 = acc[ai][bj][m][0] * rs, v1 = acc[ai][bj][m][1] * rs;
                    if (wc == 0 && sect < 2) rope4(v0, v1, cs0, cs1);
                    if (sect == 0) { v0 *= QSCALE; v1 *= QSCALE; }
                    bf16_t* p = out + (size_t)row * 9216 + colbase + wc * 32 + 4 * fq;
                    st_bf4(p, v0); st_bf4(p + 16, v1);
                }
            }
    }
};
struct EpiKVQG {
    static constexpr bool PERM = false, AFTER_DRAIN = false;
    bf16_t* kv; bf16_t* q1; float* gates; const float* sumsq; const float* rope;
    DI void operator()(const f32x4 (&acc)[2][2][4][2], const Unit& u, int wr, int wc, int fr, int fq) const {
        float rsv[2][4]; rstd8(rsv, sumsq, u, wr, fr);
#pragma unroll
        for (int ai = 0; ai < 2; ++ai)
#pragma unroll
            for (int m = 0; m < 4; ++m) {
                const int row = u.pm * 256 + ai * 128 + wr * 64 + m * 16 + fr; const float rs = rsv[ai][m]; const int pos = row & (SEQ - 1), b = row >> 13;
                f32x4 cs0 = {1.f, 0.f, 1.f, 0.f}, cs1 = {1.f, 0.f, 1.f, 0.f};
                if (wc == 0) { const f32x4* rp = (const f32x4*)(rope + ((size_t)pos * 16 + 4 * fq) * 2); cs0 = rp[0]; cs1 = rp[1]; }
#pragma unroll
                for (int bj = 0; bj < 2; ++bj) {
                    const int idx = u.pn * 2 + bj;
                    f32x4 v0 = acc[ai][bj][m][0] * rs, v1 = acc[ai][bj][m][1] * rs;
                    if (idx < 24) {
                        const int cb = idx >> 2, g = idx & 3;
                        if (wc == 0 && (cb == 2 || cb == 4)) rope4(v0, v1, cs0, cs1);
                        bf16_t* p = kv + (size_t)cb * (KVSEC / 2) + ((size_t)((b * 4 + g) * SEQ + pos)) * 128 + wc * 32 + 4 * fq;
                        st_bf4(p, v0); st_bf4(p + 16, v1);
                    } else if (idx < 40) {
                        if (wc == 0) rope4(v0, v1, cs0, cs1);
                        v0 *= QSCALE; v1 *= QSCALE;
                        bf16_t* p = q1 + (size_t)row * 2048 + (idx - 24) * 128 + wc * 32 + 4 * fq;
                        st_bf4(p, v0); st_bf4(p + 16, v1);
                    } else if (idx == 40) {
                        const int c0 = wc * 32 + 4 * fq;
                        if (c0 < 48) { f32x4 s; for (int j = 0; j < 4; ++j) s[j] = sigmoidf(v0[j]); *(f32x4*)(gates + (size_t)row * 48 + c0) = s; }
                        if (c0 + 16 < 48) { f32x4 s; for (int j = 0; j < 4; ++j) s[j] = sigmoidf(v1[j]); *(f32x4*)(gates + (size_t)row * 48 + c0 + 16) = s; }
                    }
                }
            }
    }
};
struct EpiRes {
    static constexpr bool PERM = false, AFTER_DRAIN = false;
    const float* base; float* h; bf16_t* hb; float* sumsq;
    DI void operator()(const f32x4 (&acc)[2][2][4][2], const Unit& u, int wr, int wc, int fr, int fq) const {
#pragma unroll
        for (int ai = 0; ai < 2; ++ai)
#pragma unroll
            for (int m = 0; m < 4; ++m) {
                const int row = u.pm * 256 + ai * 128 + wr * 64 + m * 16 + fr; float ss = 0.f;
                const size_t off = (size_t)row * 2048 + u.pn * 256 + wc * 32 + 4 * fq;
#pragma unroll
                for (int bj = 0; bj < 2; ++bj)
#pragma unroll
                    for (int n = 0; n < 2; ++n) {
                        const size_t o = off + bj * 128 + n * 16;
                        const f32x4 v = acc[ai][bj][m][n] + *(const f32x4*)(base + o);
                        *(f32x4*)(h + o) = v; st_bf4(hb + o, v);
                        ss += (v[0] * v[0] + v[1] * v[1]) + (v[2] * v[2] + v[3] * v[3]);
                    }
                ss = xrow_sum(ss);
                if (fq == 0) atomicAdd(sumsq + row, ss);
                asm volatile("" ::: "memory");
            }
    }
};
struct EpiRelu2 {
    static constexpr bool PERM = true, AFTER_DRAIN = false;
    bf16_t* out; const float* sumsq;
    DI void operator()(const f32x4 (&acc)[2][2][4][2], const Unit& u, int wr, int wc, int fr, int fq) const {
        float rsv[2][4]; rstd8(rsv, sumsq, u, wr, fr);
#pragma unroll
        for (int ai = 0; ai < 2; ++ai)
#pragma unroll
            for (int m = 0; m < 4; ++m) {
                const int row = u.pm * 256 + ai * 128 + wr * 64 + m * 16 + fr; const float rs = rsv[ai][m];
                bf16_t* rowp = out + (size_t)row * 8192 + u.pn * 256 + wc * 32 + 8 * fq;
#pragma unroll
                for (int bj = 0; bj < 2; ++bj) {
                    f32x4 v0 = acc[ai][bj][m][0] * rs, v1 = acc[ai][bj][m][1] * rs;
#pragma unroll
                    for (int j = 0; j < 4; ++j) { v0[j] = fmaxf(v0[j], 0.f); v0[j] *= v0[j]; v1[j] = fmaxf(v1[j], 0.f); v1[j] *= v1[j]; }
                    u32x4 w; w.x = pk_bf16(v0[0], v0[1]); w.y = pk_bf16(v0[2], v0[3]); w.z = pk_bf16(v1[0], v1[1]); w.w = pk_bf16(v1[2], v1[3]);
                    *(u32x4*)(rowp + bj * 128) = w;
                }
            }
    }
};
struct EpiBf {
    static constexpr bool PERM = false, AFTER_DRAIN = false;
    bf16_t* out; int ldc;
    DI void operator()(const f32x4 (&acc)[2][2][4][2], const Unit& u, int wr, int wc, int fr, int fq) const {
#pragma unroll
        for (int ai = 0; ai < 2; ++ai)
#pragma unroll
            for (int m = 0; m < 4; ++m) {
                const int row = u.pm * 256 + ai * 128 + wr * 64 + m * 16 + fr;
                bf16_t* rowp = out + (size_t)row * ldc + u.pn * 256 + wc * 32 + 4 * fq;
#pragma unroll
                for (int bj = 0; bj < 2; ++bj)
#pragma unroll
                    for (int n = 0; n < 2; ++n) st_bf4(rowp + bj * 128 + n * 16, acc[ai][bj][m][n]);
            }
    }
};
struct EpiF32 {
    static constexpr bool PERM = false, AFTER_DRAIN = false;
    float* out; int ldc;
    DI void operator()(const f32x4 (&acc)[2][2][4][2], const Unit& u, int wr, int wc, int fr, int fq) const {
#pragma unroll
        for (int ai = 0; ai < 2; ++ai)
#pragma unroll
            for (int m = 0; m < 4; ++m) {
                const int row = u.pm * 256 + ai * 128 + wr * 64 + m * 16 + fr;
                float* rowp = out + (size_t)row * ldc + u.pn * 256 + wc * 32 + 4 * fq;
#pragma unroll
                for (int bj = 0; bj < 2; ++bj)
#pragma unroll
                    for (int n = 0; n < 2; ++n) *(f32x4*)(rowp + bj * 128 + n * 16) = acc[ai][bj][m][n];
            }
    }
};
struct EpiGate {
    static constexpr bool PERM = false, AFTER_DRAIN = false;
    float* h; bf16_t* hb; const bf16_t* proj; const float* sumsq_in; float* sumsq_out;
    DI void operator()(const f32x4 (&acc)[2][2][4][2], const Unit& u, int wr, int wc, int fr, int fq) const {
        float rsv[2][4]; rstd8(rsv, sumsq_in, u, wr, fr);
#pragma unroll
        for (int ai = 0; ai < 2; ++ai)
#pragma unroll
            for (int m = 0; m < 4; ++m) {
                const int row = u.pm * 256 + ai * 128 + wr * 64 + m * 16 + fr; const float rs = rsv[ai][m]; float ss = 0.f;
                const size_t off = (size_t)row * 2048 + u.pn * 256 + wc * 32 + 4 * fq;
#pragma unroll
                for (int bj = 0; bj < 2; ++bj)
#pragma unroll
                    for (int n = 0; n < 2; ++n) {
                        const size_t o = off + bj * 128 + n * 16;
                        const u32x2 pw = *(const u32x2*)(proj + o); const f32x4 hv = *(const f32x4*)(h + o); const f32x4 a = acc[ai][bj][m][n] * rs;
                        f32x4 v;
                        v[0] = hv[0] + bf_lo(pw.x) * sigmoidf(a[0]); v[1] = hv[1] + bf_hi(pw.x) * sigmoidf(a[1]);
                        v[2] = hv[2] + bf_lo(pw.y) * sigmoidf(a[2]); v[3] = hv[3] + bf_hi(pw.y) * sigmoidf(a[3]);
                        *(f32x4*)(h + o) = v; st_bf4(hb + o, v);
                        ss += (v[0] * v[0] + v[1] * v[1]) + (v[2] * v[2] + v[3] * v[3]);
                    }
                ss = xrow_sum(ss);
                if (fq == 0) atomicAdd(sumsq_out + row, ss);
                asm volatile("" ::: "memory");
            }
    }
};
DI void convert_T(const float* src, int K, int N, int ld, const float* g, bf16_t* dst, int pitch, LAS float* tile, int blk, int nblk) {
    int tid = threadIdx.x; asm volatile("" : "+v"(tid));
    const int ntn = (N + 63) >> 6, ntk = K >> 6, tr = tid >> 3, tc = (tid & 7) * 8;
    for (int t = blk; t < ntn * ntk; t += nblk) {
        const int tk = t / ntn, tn = t - tk * ntn;
        const int k = tk * 64 + tr, n0 = tn * 64 + tc;
        const float gg = g ? g[k] : 1.0f;
        f32x4 a = {0.f, 0.f, 0.f, 0.f}, b = {0.f, 0.f, 0.f, 0.f};
        if (n0 < N) a = *(const f32x4*)(src + (size_t)k * ld + n0);
        if (n0 + 4 < N) b = *(const f32x4*)(src + (size_t)k * ld + n0 + 4);
#pragma unroll
        for (int j = 0; j < 4; ++j) { tile[tr * 65 + tc + j] = a[j] * gg; tile[tr * 65 + tc + 4 + j] = b[j] * gg; }
        __syncthreads();
        const int n = tn * 64 + tr;
        if (n < N) {
            float v[8];
#pragma unroll
            for (int j = 0; j < 8; ++j) v[j] = tile[(tc + j) * 65 + tr];
            u32x4 w; w.x = pk_bf16(v[0], v[1]); w.y = pk_bf16(v[2], v[3]); w.z = pk_bf16(v[4], v[5]); w.w = pk_bf16(v[6], v[7]);
            *(u32x4*)(dst + (size_t)n * pitch + tk * 64 + tc) = w;
        }
        __syncthreads();
    }
}
DI void convert_layer_mlp(const Args& a, int layer, LAS float* tile) {
    unsigned char* ws = a.ws; const int blk = blockIdx.x, nblk = gridDim.x;
    convert_T(a.in[16] + (size_t)layer * 2048 * 8192, 2048, 8192, 8192, a.in[15] + layer * 2048, (bf16_t*)(ws + WS_W_MLP1), 2048, tile, blk, nblk);
    convert_T(a.in[17] + (size_t)layer * 8192 * 2048, 8192, 2048, 2048, nullptr, (bf16_t*)(ws + WS_W_MLP2), 8192, tile, blk, nblk);
}
DI void convert_layer_ple(const Args& a, int layer, LAS float* tile) {
    unsigned char* ws = a.ws; const int blk = blockIdx.x, nblk = gridDim.x;
    convert_T(a.in[19] + (size_t)layer * 2048 * 2048, 2048, 2048, 2048, a.in[18] + layer * 2048, (bf16_t*)(ws + WS_W_GATE), 2048, tile, blk, nblk);
    convert_T(a.in[20] + (size_t)layer * 256 * 2048, 256, 2048, 2048, nullptr, (bf16_t*)(ws + WS_W_PROJ), 256, tile, blk, nblk);
}
DI void convert_layer1_attn(const Args& a, LAS float* tile) {
    unsigned char* ws = a.ws; const int blk = blockIdx.x, nblk = gridDim.x;
    bf16_t* kvqg = (bf16_t*)(ws + W1_KVQG);
    convert_T(a.in[7], 2048, 3072, 3072, a.in[6], kvqg, 2048, tile, blk, nblk);
    convert_T(a.in[4], 2048, 2096, 2096, a.in[14] + 2048, kvqg + (size_t)3072 * 2048, 2048, tile, blk, nblk);
    { u32x4 z = {0u, 0u, 0u, 0u}; u32x4* p = (u32x4*)(kvqg + (size_t)5168 * 2048);
      for (int i = blk * 512 + (int)threadIdx.x; i < 208 * 2048 / 8; i += nblk * 512) p[i] = z; }
    convert_T(a.in[5], 2048, 2048, 2048, nullptr, (bf16_t*)(ws + W1_BOUT), 2048, tile, blk, nblk);
    convert_T(a.in[9], 2048, 256, 256, nullptr, (bf16_t*)(ws + W1_C1K), 2048, tile, blk, nblk);
    convert_T(a.in[9] + 2048 * 256, 2048, 256, 256, nullptr, (bf16_t*)(ws + W1_C1K) + (size_t)256 * 2048, 2048, tile, blk, nblk);
    convert_T(a.in[12], 2048, 256, 256, nullptr, (bf16_t*)(ws + W1_C1V), 2048, tile, blk, nblk);
    convert_T(a.in[12] + 2048 * 256, 2048, 256, 256, nullptr, (bf16_t*)(ws + W1_C1V) + (size_t)256 * 2048, 2048, tile, blk, nblk);
    convert_T(a.in[10], 256, 128, 128, nullptr, (bf16_t*)(ws + W1_C2K), 256, tile, blk, nblk);
    convert_T(a.in[13], 256, 128, 128, nullptr, (bf16_t*)(ws + W1_C2V), 256, tile, blk, nblk);
}
DI void phase_prologue(const Args& a, LAS unsigned char* lds) {
    unsigned char* ws = a.ws; int tid = threadIdx.x; asm volatile("" : "+v"(tid)); const int blk = blockIdx.x, nblk = gridDim.x, lane = tid & 63, wid = tid >> 6;
    const size_t gtid = (size_t)blk * 512 + tid, nthr = (size_t)nblk * 512;
    { const float* x = a.in[0]; bf16_t* hb = (bf16_t*)(ws + WS_HB); float* ss0 = (float*)(ws + WS_SUMSQ);
      for (int row = blk * 8 + wid; row < T; row += nblk * 8) {
          float ss = 0.f;
#pragma unroll
          for (int i = 0; i < 8; ++i) { const int c = (i * 64 + lane) * 4; const f32x4 v = *(const f32x4*)(x + (size_t)row * 2048 + c);
              ss += (v[0] * v[0] + v[1] * v[1]) + (v[2] * v[2] + v[3] * v[3]); st_bf4(hb + (size_t)row * 2048 + c, v); }
#pragma unroll
          for (int o = 1; o < 64; o <<= 1) ss += __shfl_xor(ss, o);
          if (lane == 0) ss0[row] = ss;
      } }
    { float* s = (float*)(ws + WS_SUMSQ) + T; for (size_t i = gtid; i < (size_t)6 * T; i += nthr) s[i] = 0.f; }
    { const float* p = a.in[1]; bf16_t* pb = (bf16_t*)(ws + WS_PB);
      for (size_t i = gtid; i < (size_t)2 * T * 256 / 8; i += nthr) { const f32x4 v0 = *(const f32x4*)(p + i * 8), v1 = *(const f32x4*)(p + i * 8 + 4);
          u32x4 w; w.x = pk_bf16(v0[0], v0[1]); w.y = pk_bf16(v0[2], v0[3]); w.z = pk_bf16(v1[0], v1[1]); w.w = pk_bf16(v1[2], v1[3]); *(u32x4*)(pb + i * 8) = w; } }
    { float* rope = (float*)(ws + WS_ROPE);
      for (size_t i = gtid; i < (size_t)SEQ * 16; i += nthr) { const int pos = (int)(i >> 4), fi = (int)(i & 15); const float ang = (float)pos * a.inv_freq[fi];
          double rv = (double)ang * 0.15915494309189535; rv -= floor(rv); const float fr = (float)rv;
          rope[i * 2] = __builtin_amdgcn_cosf(fr); rope[i * 2 + 1] = __builtin_amdgcn_sinf(fr); } }
    if (blk < 32) { const int job = blk * 2 + (tid >> 8), kv = job >> 5, l = job & 31, col = tid & 255;
        const float* pe = a.in[kv ? 11 : 8] + l * 128; const float* w1 = a.in[kv ? 12 : 9] + (size_t)l * 128 * 256 + col; float s = 0.f;
#pragma unroll 8
        for (int d = 0; d < 128; ++d) s += pe[d] * w1[(size_t)d * 256];
        ((float*)(ws + WS_CPART))[job * 256 + col] = s; }
    LAS float* tile = (LAS float*)lds;
    convert_T(a.in[2], 2048, 9216, 9216, a.in[14], (bf16_t*)(ws + WS_W_IN), 2048, tile, blk, nblk);
    convert_T(a.in[3], 1024, 2048, 2048, nullptr, (bf16_t*)(ws + WS_W_OUT), 1024, tile, blk, nblk);
    convert_layer_mlp(a, 0, tile);
    convert_layer_ple(a, 0, tile);
}
constexpr int KV_PITCH = 288, V_PITCH = 288, KV_TILE = 64 * KV_PITCH, V_TILE = 64 * V_PITCH, KV_BUF = KV_TILE + V_TILE, ATT_WAVE_OFF = 2 * KV_BUF, ATT_WAVE_BYTES = 2304;
#define MFMA16(a, b, c) __builtin_amdgcn_mfma_f32_16x16x32_bf16((a), (b), (c), 0, 0, 0)
struct StageRegs { u32x4 k[2], v[2]; };
template <bool LOADV> DI void stage_issue(StageRegs& r, const bf16_t* kb, const bf16_t* vb, size_t pitch, int tid) {
#pragma unroll
    for (int i = 0; i < 2; ++i) { const int c = tid + 512 * i, row = c >> 4, ch = c & 15;
        r.k[i] = *(const u32x4*)(kb + (size_t)row * pitch + ch * 8);
        if (LOADV) r.v[i] = *(const u32x4*)(vb + (size_t)row * pitch + ch * 8); }
}
template <bool LOADV> DI void stage_write(LAS unsigned char* kl, const StageRegs& r, int tid) {
#pragma unroll
    for (int i = 0; i < 2; ++i) { const int c = tid + 512 * i, row = c >> 4, ch = c & 15;
        *(LAS u32x4*)(kl + row * KV_PITCH + ch * 16) = r.k[i];
        if (LOADV) *(LAS u32x4*)(kl + KV_TILE + row * V_PITCH + ch * 16) = r.v[i]; }
}
template <bool LOADV, class F> DI void tile_loop(const bf16_t* kb, const bf16_t* vb, size_t pitch, int ntiles, LAS unsigned char* lds, int tid, const F& f) {
    if (ntiles <= 0) return;
    StageRegs sr;
    stage_issue<LOADV>(sr, kb, vb, pitch, tid);
    stage_write<LOADV>(lds, sr, tid);
    __syncthreads();
    for (int i = 0; i < ntiles; ++i) {
        LAS unsigned char* kl = lds + (i & 1) * KV_BUF;
        if (i + 1 < ntiles) stage_issue<LOADV>(sr, kb + (size_t)(i + 1) * 64 * pitch, vb + (size_t)(i + 1) * 64 * pitch, pitch, tid);
        f(i, kl, kl + KV_TILE);
        if (i + 1 < ntiles) stage_write<LOADV>(lds + ((i + 1) & 1) * KV_BUF, sr, tid);
        __syncthreads();
    }
}
DI float quad_sum(float v) {
    v += __uint_as_float((unsigned)__builtin_amdgcn_update_dpp(0, (int)__float_as_uint(v), 0xB1, 0xF, 0xF, true));
    v += __uint_as_float((unsigned)__builtin_amdgcn_update_dpp(0, (int)__float_as_uint(v), 0x4E, 0xF, 0xF, true));
    return v;
}
struct AttnAcc { f32x4 o[8]; f32x4 ls; float m, l; };
DI void acc_reset(AttnAcc& a) {
#pragma unroll
    for (int n = 0; n < 8; ++n) a.o[n] = (f32x4){0.f, 0.f, 0.f, 0.f};
    a.m = M_INIT; a.l = 0.f; a.ls = (f32x4){0.f, 0.f, 0.f, 0.f};
}
template <int MODE, class MaskF, class PF>
DI void attn_tile(LAS const unsigned char* kl, LAS const unsigned char* vl, const bf16x8 (&qf)[4], AttnAcc& A, float inv_l, bool allkeys, bool lane_ok, const MaskF& valid, const PF& pf, int lane) {
    const int r16 = lane & 15, g4 = lane >> 4;
    f32x4 s[4];
#pragma unroll
    for (int kt = 0; kt < 4; ++kt) { s[kt] = (f32x4){0.f, 0.f, 0.f, 0.f};
#pragma unroll
        for (int ks = 0; ks < 4; ++ks) { const bf16x8 kf = *(LAS const bf16x8*)(kl + (16 * kt + r16) * KV_PITCH + ks * 64 + g4 * 16); s[kt] = MFMA16(kf, qf[ks], s[kt]); } }
    float tmax = NEGBIG;
    if (__builtin_amdgcn_readfirstlane((int)allkeys)) {
#pragma unroll
        for (int kt = 0; kt < 4; ++kt) tmax = fmaxf(tmax, fmaxf(fmaxf(s[kt][0], s[kt][1]), fmaxf(s[kt][2], s[kt][3])));
        tmax = lane_ok ? tmax : NEGBIG;
    } else {
#pragma unroll
        for (int kt = 0; kt < 4; ++kt)
#pragma unroll
            for (int i = 0; i < 4; ++i) { const bool ok = lane_ok && valid(16 * kt + 4 * g4 + i); const float sv = ok ? s[kt][i] : NEGBIG; s[kt][i] = sv; tmax = fmaxf(tmax, sv); }
    }
    float mref = A.m;
    if (MODE != 2) {
        if (__any(tmax > A.m + 8.0f)) {
            tmax = xrow_max(tmax);
            const float mn = fmaxf(A.m, tmax), alpha = __builtin_amdgcn_exp2f(A.m - mn);
            A.m = mn;
            if (MODE == 1) A.l *= alpha;
            if (MODE == 0) { A.ls *= alpha;
#pragma unroll
                for (int n = 0; n < 8; ++n) A.o[n] *= alpha; }
        }
        mref = A.m;
    }
    mref = lane_ok ? mref : 1e30f;
    float psum = 0.f;
#pragma unroll
    for (int kt = 0; kt < 4; ++kt)
#pragma unroll
        for (int i = 0; i < 4; ++i) { float p = __builtin_amdgcn_exp2f(s[kt][i] - mref); if (MODE == 2) p *= inv_l; s[kt][i] = p; psum += p; }
    if (MODE == 1) A.l += psum;
    if (MODE == 1) return;
    if (MODE == 2) {
#pragma unroll
        for (int kt = 0; kt < 4; ++kt) pf(kt, s[kt]); }
    const int q = r16 >> 2, pp = r16 & 3;
    LAS const unsigned char* vb = vl + (4 * g4 + q) * V_PITCH + pp * 8;
#pragma unroll
    for (int kk = 0; kk < 2; ++kk) {
        u32x4 pw; pw.x = pk_bf16(s[2 * kk][0], s[2 * kk][1]); pw.y = pk_bf16(s[2 * kk][2], s[2 * kk][3]); pw.z = pk_bf16(s[2 * kk + 1][0], s[2 * kk + 1][1]); pw.w = pk_bf16(s[2 * kk + 1][2], s[2 * kk + 1][3]);
        const bf16x8 pfrag = __builtin_bit_cast(bf16x8, pw);
        if (MODE == 0) { const bf16x8 ones = {0x3F80, 0x3F80, 0x3F80, 0x3F80, 0x3F80, 0x3F80, 0x3F80, 0x3F80}; A.ls = MFMA16(ones, pfrag, A.ls); }
#pragma unroll
        for (int n = 0; n < 8; ++n) {
            const s16x4 lo = __builtin_amdgcn_ds_read_tr16_b64_v4i16((LAS s16x4*)(vb + (32 * kk) * V_PITCH + n * 32));
            const s16x4 hi = __builtin_amdgcn_ds_read_tr16_b64_v4i16((LAS s16x4*)(vb + (32 * kk + 16) * V_PITCH + n * 32));
            const bf16x8 vf = __builtin_shufflevector(lo, hi, 0, 1, 2, 3, 4, 5, 6, 7);
            A.o[n] = MFMA16(vf, pfrag, A.o[n]);
        }
    }
}
struct NoPF { DI void operator()(int, const f32x4&) const {} };
DI void load_qf(bf16x8 (&qf)[4], const bf16_t* qrow, int g4) {
#pragma unroll
    for (int ks = 0; ks < 4; ++ks) qf[ks] = *(const bf16x8*)(qrow + ks * 32 + g4 * 8);
}

DI void phase_dilated(const bf16_t* qkv, bf16_t* og, float* lse, LAS unsigned char* lds) {
    int tid = threadIdx.x; asm volatile("" : "+v"(tid)); const int lane = tid & 63, wid = tid >> 6, r16 = lane & 15, g4 = lane >> 4;
    for (int it0 = blockIdx.x; it0 < 3072; it0 += gridDim.x) {
        const int it = (it0 & ~255) | ((it0 & 7) << 5) | ((it0 >> 3) & 31);
        const int b = it / 1536, rem = it - b * 1536, hh = rem >> 6, w = rem & 63, g = hh >> 3, dsh = 2 * g, dil = 1 << dsh, r = w >> (6 - dsh), tile = w & ((64 >> dsh) - 1);
        const int i0 = tile * 128;
        const bf16_t* qbase = qkv + (size_t)(b * SEQ + r) * 9216 + hh * 128;
        const size_t pitch = (size_t)dil * 9216;
        const int iq = i0 + wid * 16 + r16;
        bf16x8 qf[4]; load_qf(qf, qbase + (size_t)iq * pitch, g4);
        AttnAcc A; acc_reset(A);
        const int kt0 = (i0 == 0) ? 2 : 0;
        const int j0 = i0 - 128 + 64 * kt0;
        tile_loop<true>(qbase + 3072 + (size_t)j0 * pitch, qbase + 6144 + (size_t)j0 * pitch, pitch, 4 - kt0, lds, tid, [&](int i, LAS unsigned char* kl, LAS unsigned char* vl) {
            const int rel0 = 64 * (kt0 + i);
            if (rel0 <= 16 * wid + 143 && rel0 + 63 >= 16 * wid) {
                const int jb = i0 - 128 + rel0;
                const int iqlo = i0 + wid * 16;
                attn_tile<0>(kl, vl, qf, A, 0.f, jb + 63 <= iqlo && jb >= iqlo + 15 - 128, true, [&](int off) { return (unsigned)(iq - jb - off) <= 128u; }, NoPF(), lane);
            }
        });
        const float l = A.ls[0];
        const float inv = 1.0f / l;
        const size_t row = (size_t)b * SEQ + r + (size_t)dil * iq;
        bf16_t* op = og + row * 3072 + hh * 128 + 4 * g4;
#pragma unroll
        for (int n = 0; n < 8; ++n) st_bf4(op + 16 * n, A.o[n] * inv);
        if (g4 == 0) lse[row * 24 + hh] = A.m + __builtin_amdgcn_logf(l);
    }
}
DI void phase_combine(const bf16_t* og, const float* lse, bf16_t* o0) {
    int tid_ = threadIdx.x; asm volatile("" : "+v"(tid_)); const size_t gtid = (size_t)blockIdx.x * 512 + tid_, nthr = (size_t)gridDim.x * 512;
    for (size_t idx = gtid; idx < (size_t)T * 128; idx += nthr) {
        const size_t row = idx >> 7; const int c = (int)(idx & 127), h = c >> 4, d8 = (c & 15) * 8;
        const float l0 = lse[row * 24 + h], l1 = lse[row * 24 + 8 + h], l2 = lse[row * 24 + 16 + h];
        const float mx = fmaxf(l0, fmaxf(l1, l2));
        float w0 = __builtin_amdgcn_exp2f(l0 - mx), w1 = __builtin_amdgcn_exp2f(l1 - mx), w2 = __builtin_amdgcn_exp2f(l2 - mx);
        const float inv = 1.0f / (w0 + w1 + w2); w0 *= inv; w1 *= inv; w2 *= inv;
        const u32x4 a = *(const u32x4*)(og + row * 3072 + h * 128 + d8), b = *(const u32x4*)(og + row * 3072 + (8 + h) * 128 + d8), c2 = *(const u32x4*)(og + row * 3072 + (16 + h) * 128 + d8);
        u32x4 o;
#pragma unroll
        for (int j = 0; j < 4; ++j) o[j] = pk_bf16(w0 * bf_lo(a[j]) + w1 * bf_lo(b[j]) + w2 * bf_lo(c2[j]), w0 * bf_hi(a[j]) + w1 * bf_hi(b[j]) + w2 * bf_hi(c2[j]));
        *(u32x4*)(o0 + row * 1024 + h * 128 + d8) = o;
    }
}
DI float gelu_tanh(float x) { const float y = 0.7978845608028654f * (x + 0.044715f * x * x * x); const float e = __expf(2.0f * y); return 0.5f * x * (2.0f - 2.0f / (1.0f + e)); }
DI void phase_cmp2(const Args& a, LAS unsigned char* lds) {
    unsigned char* ws = a.ws; int tid = threadIdx.x; asm volatile("" : "+v"(tid)); const int lane = tid & 63, wid = tid >> 6, r16 = lane & 15, g4 = lane >> 4;
    LAS float* cvec = (LAS float*)lds;
    { const float* cp = (const float*)(ws + WS_CPART) + (tid >> 8) * 32 * 256 + (tid & 255); float s = 0.f;
      for (int l = 0; l < 32; ++l) s += cp[l * 256];
      cvec[tid] = s; }
    __syncthreads();
    const float* rope = (const float*)(ws + WS_ROPE);
    for (int wi = blockIdx.x * 8 + wid; wi < 512; wi += gridDim.x * 8) {
        const int kv = wi >> 8, bg = (wi >> 5) & 7, n0 = (wi & 31) * 16;
        const float* PQ = (const float*)(ws + (kv ? R_PQV : R_PQK)); const bf16_t* w2t = (const bf16_t*)(ws + (kv ? W1_C2V : W1_C2K));
        bf16_t* dst = (bf16_t*)(ws + (kv ? R_VCMP : R_KCMP));
        const int n = n0 + r16, n1 = n + 1 < 512 ? n + 1 : 511;
        const float* Pp = PQ + (size_t)(bg * 512 + n) * 512; const float* Qp = PQ + (size_t)(bg * 512 + n1) * 512 + 256;
        f32x4 acc[8];
#pragma unroll
        for (int nt = 0; nt < 8; ++nt) acc[nt] = (f32x4){0.f, 0.f, 0.f, 0.f};
#pragma unroll
        for (int ks = 0; ks < 8; ++ks) {
            const int k0 = ks * 32 + g4 * 8;
            const f32x4 p0 = *(const f32x4*)(Pp + k0), p1 = *(const f32x4*)(Pp + k0 + 4), q0 = *(const f32x4*)(Qp + k0), q1 = *(const f32x4*)(Qp + k0 + 4);
            float hv[8];
#pragma unroll
            for (int j = 0; j < 4; ++j) { hv[j] = gelu_tanh(p0[j] + q0[j] + cvec[kv * 256 + k0 + j]); hv[4 + j] = gelu_tanh(p1[j] + q1[j] + cvec[kv * 256 + k0 + 4 + j]); }
            u32x4 aw; aw.x = pk_bf16(hv[0], hv[1]); aw.y = pk_bf16(hv[2], hv[3]); aw.z = pk_bf16(hv[4], hv[5]); aw.w = pk_bf16(hv[6], hv[7]);
            const bf16x8 af = __builtin_bit_cast(bf16x8, aw);
#pragma unroll
            for (int nt = 0; nt < 8; ++nt) { const bf16x8 bfr = *(const bf16x8*)(w2t + (size_t)(16 * nt + r16) * 256 + k0); acc[nt] = MFMA16(af, bfr, acc[nt]); }
        }
#pragma unroll
        for (int i = 0; i < 4; ++i) {
            const int nn = n0 + 4 * g4 + i;
            if (kv == 0) { const int pos = 16 * nn + 31; const f32x2 cs = *(const f32x2*)(rope + ((size_t)(pos & (SEQ - 1)) * 16 + r16) * 2);
                const float x1 = acc[0][i], x2 = acc[1][i]; acc[0][i] = x1 * cs.x - x2 * cs.y; acc[1][i] = x2 * cs.x + x1 * cs.y; }
#pragma unroll
            for (int nt = 0; nt < 8; ++nt) { const float v = nn < 511 ? acc[nt][i] : 0.f; dst[(size_t)(bg * 512 + nn) * 128 + 16 * nt + r16] = (bf16_t)(pk_bf16(v, 0.f) & 0xffffu); }
        }
    }
}
DI void phase_nsa(const Args& a, LAS unsigned char* lds) {
    unsigned char* ws = a.ws; int tid0 = threadIdx.x;
    const bf16_t* q1 = (const bf16_t*)(ws + R_Q1); const float* gates = (const float*)(ws + R_GATES); bf16_t* o1 = (bf16_t*)(ws + R_O1);
    for (int it = blockIdx.x; it < 2048; it += gridDim.x) {
        int tid = tid0; asm volatile("" : "+v"(tid));
        const int lane = tid & 63, wid = tid >> 6, r16 = lane & 15, g4 = lane >> 4, qi = r16 >> 2, hh = r16 & 3;
        LAS float* imp = (LAS float*)(lds + ATT_WAVE_OFF + wid * ATT_WAVE_BYTES);
        LAS unsigned long long* selm = (LAS unsigned long long*)(lds + ATT_WAVE_OFF + wid * ATT_WAVE_BYTES + 2048);
        const int k8 = it >> 8, jr = it & 255, jj = ((jr & 7) << 5) | (jr >> 3), tile = (k8 & 1) ? 255 - jj : jj, b = k8 >> 2, g = k8 & 3, bg = b * 4 + g;
        const int t0 = tile * 32, tq = t0 + wid * 4 + qi; const size_t row = (size_t)b * SEQ + tq;
        bf16x8 qf[4]; load_qf(qf, q1 + row * 2048 + (g * 4 + hh) * 128, g4);
        const bf16_t* kc = (const bf16_t*)(ws + R_KCMP) + (size_t)bg * 512 * 128; const bf16_t* vc = (const bf16_t*)(ws + R_VCMP) + (size_t)bg * 512 * 128;
        const bf16_t* ksl = (const bf16_t*)(ws + R_KV + 2 * KVSEC) + (size_t)bg * SEQ * 128; const bf16_t* vsl = (const bf16_t*)(ws + R_KV + 3 * KVSEC) + (size_t)bg * SEQ * 128;
        const bf16_t* kwn = (const bf16_t*)(ws + R_KV + 4 * KVSEC) + (size_t)bg * SEQ * 128; const bf16_t* vwn = (const bf16_t*)(ws + R_KV + 5 * KVSEC) + (size_t)bg * SEQ * 128;
        const float gt0 = gates[row * 48 + g * 4 + hh], gt1 = gates[row * 48 + 16 + g * 4 + hh], gt2 = gates[row * 48 + 32 + g * 4 + hh];
        const int ncv = tq >= 31 ? ((tq - 31) >> 4) + 1 : 0;
        const int ntc = ((t0 >> 4) + 1 + 63) >> 6;
        const int tq_min = t0 + wid * 4, ncv_min = tq_min >= 31 ? ((tq_min - 31) >> 4) + 1 : 0;
#pragma unroll
        for (int i = 0; i < 8; ++i) imp[i * 64 + lane] = 0.f;
        AttnAcc A; acc_reset(A);
        tile_loop<false>(kc, vc, 128, ntc, lds, tid, [&](int i, LAS unsigned char* kl, LAS unsigned char* vl) {
            attn_tile<1>(kl, vl, qf, A, 0.f, 64 * i + 64 <= ncv_min, true, [&](int off) { return 64 * i + off < ncv; }, NoPF(), lane); });
        float lc = A.l; lc = xrow_sum(lc);
        const float inv_lc = lc > 0.f ? 1.0f / lc : 0.f;
        tile_loop<true>(kc, vc, 128, ntc, lds, tid, [&](int i, LAS unsigned char* kl, LAS unsigned char* vl) {
            attn_tile<2>(kl, vl, qf, A, inv_lc, 64 * i + 64 <= ncv_min, true, [&](int off) { return 64 * i + off < ncv; },
                [&](int kt, const f32x4& p) {
                    float mainv = (p[0] + p[1]) + (p[2] + 0.5f * p[3]), halfv = 0.5f * p[3];
                    mainv = quad_sum(mainv); halfv = quad_sum(halfv);
                    const int j = 16 * i + 4 * kt + g4;
                    asm volatile("" ::: "memory");
                    if (hh == 0) imp[qi * 128 + j] += mainv;
                    asm volatile("" ::: "memory");
                    if (hh == 0 && j + 1 < 128) imp[qi * 128 + j + 1] += halfv;
                    asm volatile("" ::: "memory");
                }, lane); });
        u32x2 totp[8];
#pragma unroll
        for (int n = 0; n < 8; ++n) { const f32x4 v = A.o[n] * gt0; totp[n].x = pk_bf16(v[0], v[1]); totp[n].y = pk_bf16(v[2], v[3]); }
        const int cur = t0 >> 6;
#pragma unroll 1
        for (int qq = 0; qq < 4; ++qq) {
            const float s0 = imp[qq * 128 + lane], s1 = imp[qq * 128 + 64 + lane];
            const int ja = lane, jb = lane + 64;
            const unsigned b0 = (ja == 0 || ja == cur || ja == cur - 1) ? 0x4E6E6B28u : __float_as_uint(s0);
            const unsigned b1 = (jb == cur || jb == cur - 1) ? 0x4E6E6B28u : __float_as_uint(s1);
            const unsigned long long k0 = ja <= cur ? ((((unsigned long long)b0) << 7) | (unsigned long long)(127 - ja)) + 1ull : 0ull;
            const unsigned long long k1 = jb <= cur ? ((((unsigned long long)b1) << 7) | (unsigned long long)(127 - jb)) + 1ull : 0ull;
            unsigned long long pre = 0ull;
#pragma unroll 1
            for (int bit = 39; bit >= 0; --bit) {
                const unsigned long long trial = pre | (1ull << bit);
                const int cnt = __popcll(__ballot(k0 >= trial)) + __popcll(__ballot(k1 >= trial));
                if (cnt >= 16) pre = trial;
            }
            if (pre == 0ull) pre = 1ull;
            const unsigned long long mlo = __ballot(k0 >= pre), mhi = __ballot(k1 >= pre);
            if (lane == 0) { selm[qq * 2] = mlo; selm[qq * 2 + 1] = mhi; }
        }
        const unsigned long long mylo = selm[qi * 2], myhi = selm[qi * 2 + 1];
        if (hh == 0 && g4 == 0) { unsigned long long* sp = (unsigned long long*)(ws + WS_SEL) + (row * 4 + g) * 2; sp[0] = mylo; sp[1] = myhi; }
        acc_reset(A);
        const int jlo = t0 >= 511 ? (t0 - 511) >> 6 : 0;
        tile_loop<true>(kwn + (size_t)jlo * 64 * 128, vwn + (size_t)jlo * 64 * 128, 128, cur + 1 - jlo, lds, tid, [&](int i, LAS unsigned char* kl, LAS unsigned char* vl) {
            const int kb = 64 * (jlo + i);
            attn_tile<0>(kl, vl, qf, A, 0.f, kb + 63 <= tq_min && kb >= tq_min + 3 - 511, true, [&](int off) { return (unsigned)(tq - kb - off) < 512u; }, NoPF(), lane); });
        bf16_t* op = o1 + row * 2048 + (g * 4 + hh) * 128 + 4 * g4;
        { const float l = A.ls[0]; const float sc = gt2 / l;
#pragma unroll
          for (int n = 0; n < 8; ++n) { f32x4 v = A.o[n] * sc; v[0] += bf_lo(totp[n].x); v[1] += bf_hi(totp[n].x); v[2] += bf_lo(totp[n].y); v[3] += bf_hi(totp[n].y); st_bf4(op + 16 * n, v); } }
    }
}

DI void phase_nsa_slc(const Args& a, LAS unsigned char* lds) {
    unsigned char* ws = a.ws; const int tid0 = threadIdx.x;
    const bf16_t* q1 = (const bf16_t*)(ws + R_Q1); const float* gates = (const float*)(ws + R_GATES); bf16_t* o1 = (bf16_t*)(ws + R_O1);
    for (int it = blockIdx.x; it < 1024; it += gridDim.x) {
        int tid = tid0; asm volatile("" : "+v"(tid));
        const int lane = tid & 63, wid = __builtin_amdgcn_readfirstlane(tid >> 6), r16 = lane & 15, g4 = lane >> 4, qi = r16 >> 2, hh = r16 & 3;
        const int k8 = it >> 7, jr = it & 127, jj = ((jr & 7) << 4) | (jr >> 3), tile = ((it >> 8) & 1) ? 127 - jj : jj, b = k8 >> 2, g = k8 & 3, bg = b * 4 + g;
        const int t0 = tile * 64, cur = tile;
        const bf16_t* ksl = (const bf16_t*)(ws + R_KV + 2 * KVSEC) + (size_t)bg * SEQ * 128; const bf16_t* vsl = (const bf16_t*)(ws + R_KV + 3 * KVSEC) + (size_t)bg * SEQ * 128;
        const int tqa = t0 + wid * 4 + qi, tqb = tqa + 32; const size_t rowa = (size_t)b * SEQ + tqa, rowb = rowa + 32;
        bf16x8 qfa[4], qfb[4]; load_qf(qfa, q1 + rowa * 2048 + (g * 4 + hh) * 128, g4); load_qf(qfb, q1 + rowb * 2048 + (g * 4 + hh) * 128, g4);
        float gta = gates[rowa * 48 + 16 + g * 4 + hh], gtb = gates[rowb * 48 + 16 + g * 4 + hh];
        const unsigned long long* sel = (const unsigned long long*)(ws + WS_SEL);
        unsigned long long alo = sel[(rowa * 4 + g) * 2], ahi = sel[(rowa * 4 + g) * 2 + 1], blo = sel[(rowb * 4 + g) * 2], bhi = sel[(rowb * 4 + g) * 2 + 1];
        asm volatile("" : "+v"(gta), "+v"(gtb), "+v"(alo), "+v"(ahi), "+v"(blo), "+v"(bhi));
        unsigned long long anyalo = alo, anyahi = ahi, anyblo = blo, anybhi = bhi;
        { unsigned long long v;
          v = anyalo; v |= __shfl_xor(v, 4); v |= __shfl_xor(v, 8); anyalo = v;  v = anyahi; v |= __shfl_xor(v, 4); v |= __shfl_xor(v, 8); anyahi = v;
          v = anyblo; v |= __shfl_xor(v, 4); v |= __shfl_xor(v, 8); anyblo = v;  v = anybhi; v |= __shfl_xor(v, 4); v |= __shfl_xor(v, 8); anybhi = v; }
        AttnAcc A, B; acc_reset(A); acc_reset(B);
        tile_loop<true>(ksl, vsl, 128, cur + 1, lds, tid, [&](int j, LAS unsigned char* kl, LAS unsigned char* vl) {
            const int sh = j & 63; const bool hi = j >= 64;
            const bool anya = (((hi ? anyahi : anyalo) >> sh) & 1ull) != 0ull, anyb = (((hi ? anybhi : anyblo) >> sh) & 1ull) != 0ull;
            if (__any(anya)) {
                const bool mine = (((hi ? ahi : alo) >> sh) & 1ull) != 0ull;
                attn_tile<0>(kl, vl, qfa, A, 0.f, j < cur, mine, [&](int off) { return 64 * j + off <= tqa; }, NoPF(), lane);
            }
            if (__any(anyb)) {
                const bool mine = (((hi ? bhi : blo) >> sh) & 1ull) != 0ull;
                attn_tile<0>(kl, vl, qfb, B, 0.f, j < cur, mine, [&](int off) { return 64 * j + off <= tqb; }, NoPF(), lane);
            } });
        { const float l = A.ls[0]; const float sc = gta / l; bf16_t* op = o1 + rowa * 2048 + (g * 4 + hh) * 128 + 4 * g4;
#pragma unroll
          for (int n = 0; n < 8; ++n) { const u32x2 pw = *(const u32x2*)(op + 16 * n); f32x4 v = A.o[n] * sc; v[0] += bf_lo(pw.x); v[1] += bf_hi(pw.x); v[2] += bf_lo(pw.y); v[3] += bf_hi(pw.y); st_bf4(op + 16 * n, v); } }
        { const float l = B.ls[0]; const float sc = gtb / l; bf16_t* op = o1 + rowb * 2048 + (g * 4 + hh) * 128 + 4 * g4;
#pragma unroll
          for (int n = 0; n < 8; ++n) { const u32x2 pw = *(const u32x2*)(op + 16 * n); f32x4 v = B.o[n] * sc; v[0] += bf_lo(pw.x); v[1] += bf_hi(pw.x); v[2] += bf_lo(pw.y); v[3] += bf_hi(pw.y); st_bf4(op + 16 * n, v); } }
    }
}
DI void phase_final(float* h, const float* sumsq, const float* g) {
    int tid_ = threadIdx.x; asm volatile("" : "+v"(tid_)); const size_t gtid = (size_t)blockIdx.x * 512 + tid_, nthr = (size_t)gridDim.x * 512;
    for (size_t i = gtid; i < (size_t)T * 512; i += nthr) { const int row = (int)(i >> 9), c4 = (int)(i & 511) * 4; const float rs = rstd_of(sumsq, row);
        const f32x4 v = *(const f32x4*)(h + i * 4), gg = *(const f32x4*)(g + c4); *(f32x4*)(h + i * 4) = v * rs * gg; }
}
#define XB_TMO      128
#define XB_XCNT(j)  (256  + 64 * (j))
#define XB_XSUB(j)  (1280 + 64 * (j))
#define XB_XGEN(j)  (2304 + 64 * (j))
#define XB_TOP      3328
#define XB_TOPGEN   3392
#define XCD_BAR_WORDS 3456
#define XB_SPIN_CAP (1u << 18)

__device__ __forceinline__ unsigned xb_ld(unsigned* p)              { return __hip_atomic_load(p, __ATOMIC_RELAXED, __HIP_MEMORY_SCOPE_AGENT); }
__device__ __forceinline__ unsigned xb_add(unsigned* p, unsigned v) { return __hip_atomic_fetch_add(p, v, __ATOMIC_RELAXED, __HIP_MEMORY_SCOPE_AGENT); }
__device__ __forceinline__ unsigned xb_xcc_id() { return (unsigned)__builtin_amdgcn_s_getreg((3 << 11) | 20) & 0xFu; }
#define XB_SPIN(cond, bar) do { unsigned _sp = 0; while (cond) { __builtin_amdgcn_s_sleep(1); \
    if ((++_sp & 255u) == 0u) { if (xb_ld(&(bar)[XB_TMO])) break; if (_sp > XB_SPIN_CAP) { atomicAdd(&(bar)[XB_TMO], 1u); break; } } } } while (0)

struct XcdBarrier {
    unsigned* bar; unsigned x;
    volatile LAS unsigned* st;
};

__device__ __forceinline__ XcdBarrier xcd_barrier_post(unsigned* bar, volatile LAS unsigned* st) {
    XcdBarrier b; b.bar = bar; b.x = xb_xcc_id(); b.st = st;
    if (threadIdx.x == 0) (void)xb_add(&bar[XB_XCNT(b.x)], 1u);
    return b;
}
__device__ __forceinline__ void xcd_barrier_complete(unsigned* bar, unsigned x, unsigned& nloc, unsigned& nx) {
    const unsigned G = gridDim.x * gridDim.y * gridDim.z;
    unsigned sum, cnt, mine, sp = 0u;
    for (;;) {
        sum = 0u; cnt = 0u; mine = 0u;
#pragma unroll
        for (unsigned j = 0; j < 16; ++j) { const unsigned c = xb_ld(&bar[XB_XCNT(j)]); sum += c; cnt += (c > 0u) ? 1u : 0u; mine = (j == x) ? c : mine; }
        if (sum == G) break;
        __builtin_amdgcn_s_sleep(1);
        if ((++sp & 255u) == 0u) { if (xb_ld(&bar[XB_TMO])) break; if (sp > XB_SPIN_CAP) { atomicAdd(&bar[XB_TMO], 1u); break; } }
    }
    nloc = mine > 0u ? mine : 1u; nx = cnt > 0u ? cnt : 1u;
}

__device__ __forceinline__ void xcd_barrier(const XcdBarrier& b) {
    asm volatile("s_waitcnt vmcnt(0)" ::: "memory");
    __syncthreads();
    if (threadIdx.x == 0) {
        unsigned* bar = b.bar;
        __builtin_amdgcn_s_waitcnt(0);
        unsigned nloc = b.st[0], nx = b.st[1];
        if (nloc == 0u) { xcd_barrier_complete(bar, b.x, nloc, nx); b.st[0] = nloc; b.st[1] = nx; }
        const unsigned old = xb_add(&bar[XB_XSUB(b.x)], 1u);
        const unsigned gen = old / nloc;
        if (old + 1u == (gen + 1u) * nloc) {
            __builtin_amdgcn_fence(__ATOMIC_RELEASE, "agent");
            asm volatile("s_waitcnt vmcnt(0)" ::: "memory");
            const unsigned og = xb_add(&bar[XB_TOP], 1u);
            const unsigned tg = og / nx;
            if (og + 1u == (tg + 1u) * nx) xb_add(&bar[XB_TOPGEN], 1u);
            else XB_SPIN(xb_ld(&bar[XB_TOPGEN]) == tg, bar);
            __builtin_amdgcn_fence(__ATOMIC_ACQUIRE, "agent");
            xb_add(&bar[XB_XGEN(b.x)], 1u);
            asm volatile("s_waitcnt vmcnt(0)" ::: "memory");
        } else {
            XB_SPIN(xb_ld(&bar[XB_XGEN(b.x)]) == gen, bar);
            __builtin_amdgcn_fence(__ATOMIC_ACQUIRE, "agent");
            asm volatile("s_waitcnt vmcnt(0)" ::: "memory");
        }
    }
    __syncthreads();
}


template <class Epi> DI void run_gemm(LAS unsigned char* lds, const bf16_t* A, const bf16_t* Bt, int M, int N, int K, const Epi& E, int cshift = 0) {
    pg8::Gemm g{A, Bt, M, N, K}; pg8::StaticOrder S; S.init(M, N, (int)gridDim.x, (int)((blockIdx.x + cshift) % gridDim.x)); pg8::gemm_phase(lds, g, S, E);
}
#ifndef PH_LO
#define PH_LO 0
#endif
#ifndef PH_HI
#define PH_HI 17
#endif
__global__ void __launch_bounds__(512, 2) yoco_fwd(Args a) {
    extern __shared__ __attribute__((aligned(16))) unsigned char lds_raw[];
    LAS unsigned char* lds = (LAS unsigned char*)lds_raw;
    cg::grid_group grid = cg::this_grid();
    unsigned char* ws = a.ws;
    float* h = a.out; const float* x = a.in[0];
    bf16_t* HB = (bf16_t*)(ws + WS_HB); bf16_t* HB3 = (bf16_t*)(ws + R_O1); const bf16_t* PB = (const bf16_t*)(ws + WS_PB);
    bf16_t* RB = (bf16_t*)(ws + WS_R); bf16_t* OG = (bf16_t*)(ws + WS_OG); bf16_t* PROJ = OG;
    float* SS = (float*)(ws + WS_SUMSQ); const float* rope = (const float*)(ws + WS_ROPE); float* LSE = (float*)(ws + WS_LSE);
    LAS float* tile = (LAS float*)lds;
    __shared__ uint4 xb_words;
    if (threadIdx.x == 0) xb_words = make_uint4(0u, 0u, 0u, 0u);
    __syncthreads();
    const XcdBarrier xb = xcd_barrier_post((unsigned*)(ws + WS_BAR), (volatile LAS unsigned*)&xb_words);
    phase_prologue(a, lds); grid.sync();
    run_gemm(lds, HB, (const bf16_t*)(ws + WS_W_IN), T, 9216, 2048, EpiQKV0{RB, SS, rope}); xcd_barrier(xb);
    phase_dilated(RB, OG, LSE, lds); xcd_barrier(xb);
    phase_combine(OG, LSE, RB); xcd_barrier(xb);
    run_gemm(lds, RB, (const bf16_t*)(ws + WS_W_OUT), T, 2048, 1024, EpiRes{x, h, HB, SS + T}); xcd_barrier(xb);
    run_gemm(lds, HB, (const bf16_t*)(ws + WS_W_MLP1), T, 8192, 2048, EpiRelu2{RB, SS + T}); xcd_barrier(xb);
    run_gemm(lds, RB, (const bf16_t*)(ws + WS_W_MLP2), T, 2048, 8192, EpiRes{h, h, HB, SS + 2 * T}); xcd_barrier(xb);
    convert_layer1_attn(a, tile); convert_layer_mlp(a, 1, tile);
    run_gemm(lds, PB, (const bf16_t*)(ws + WS_W_PROJ), T, 2048, 256, EpiBf{PROJ, 2048});
    run_gemm(lds, HB, (const bf16_t*)(ws + WS_W_GATE), T, 2048, 2048, EpiGate{h, HB3, PROJ, SS + 2 * T, SS + 3 * T}); xcd_barrier(xb);
    convert_layer_ple(a, 1, tile);
    run_gemm(lds, HB3, (const bf16_t*)(ws + W1_KVQG), T, 5376, 2048, EpiKVQG{(bf16_t*)(ws + R_KV), (bf16_t*)(ws + R_Q1), (float*)(ws + R_GATES), SS + 3 * T, rope}); xcd_barrier(xb);
    run_gemm(lds, (const bf16_t*)(ws + R_KV), (const bf16_t*)(ws + W1_C1K), 4096, 512, 2048, EpiF32{(float*)(ws + R_PQK), 512});
    run_gemm(lds, (const bf16_t*)(ws + R_KV + KVSEC), (const bf16_t*)(ws + W1_C1V), 4096, 512, 2048, EpiF32{(float*)(ws + R_PQV), 512}, (int)gridDim.x - 32); xcd_barrier(xb);
    phase_cmp2(a, lds); xcd_barrier(xb);
    phase_nsa(a, lds); xcd_barrier(xb);
    phase_nsa_slc(a, lds); xcd_barrier(xb);
    run_gemm(lds, (const bf16_t*)(ws + R_O1), (const bf16_t*)(ws + W1_BOUT), T, 2048, 2048, EpiRes{h, h, HB, SS + 4 * T}); xcd_barrier(xb);
    run_gemm(lds, HB, (const bf16_t*)(ws + WS_W_MLP1), T, 8192, 2048, EpiRelu2{RB, SS + 4 * T}); xcd_barrier(xb);
    run_gemm(lds, RB, (const bf16_t*)(ws + WS_W_MLP2), T, 2048, 8192, EpiRes{h, h, HB, SS + 5 * T}); xcd_barrier(xb);
    run_gemm(lds, PB + (size_t)T * 256, (const bf16_t*)(ws + WS_W_PROJ), T, 2048, 256, EpiBf{PROJ, 2048});
    run_gemm(lds, HB, (const bf16_t*)(ws + WS_W_GATE), T, 2048, 2048, EpiGate{h, HB3, PROJ, SS + 5 * T, SS + 6 * T}); xcd_barrier(xb);
    phase_final(h, SS + 6 * T, a.in[21]);
}

extern "C" void kernel_launch(void* const* d_in, const int* in_sizes, int n_in, void* d_out, int out_size, void* d_ws, size_t ws_size, hipStream_t stream) {
    static int grid = 0;
    constexpr int LDS_BYTES = 131072;
    if (grid == 0) {
        if (n_in != 22 || out_size != T * DM || ws_size < WS_END + 16384) { fprintf(stderr, "kernel_launch: unexpected shapes (n_in %d out %d ws %zu need %zu)\n", n_in, out_size, ws_size, (size_t)WS_END); grid = -1; return; }
        int dev = 0, cus = 0, per_cu = 0;
        if (hipGetDevice(&dev) != hipSuccess || hipDeviceGetAttribute(&cus, hipDeviceAttributeMultiprocessorCount, dev) != hipSuccess) { grid = -1; return; }
        if (hipFuncSetAttribute((const void*)yoco_fwd, hipFuncAttributeMaxDynamicSharedMemorySize, LDS_BYTES) != hipSuccess) { fprintf(stderr, "kernel_launch: hipFuncSetAttribute failed\n"); grid = -1; return; }
        if (hipOccupancyMaxActiveBlocksPerMultiprocessor(&per_cu, (const void*)yoco_fwd, 512, LDS_BYTES) != hipSuccess || per_cu < 1) { fprintf(stderr, "kernel_launch: occupancy query says %d\n", per_cu); per_cu = 1; }
        (void)hipGetLastError();
        grid = cus;
    }
    if (grid < 0) return;
    Args a{};
    for (int i = 0; i < 22; ++i) a.in[i] = (const float*)d_in[i];
    a.out = (float*)d_out; a.ws = (unsigned char*)d_ws;
    for (int i = 0; i < 16; ++i) a.inv_freq[i] = (float)std::pow(500000.0, -(double)i * (2.0 / 32.0));
    if (hipMemsetAsync((unsigned char*)d_ws + WS_BAR, 0, XCD_BAR_WORDS * 4, stream) != hipSuccess) { fprintf(stderr, "kernel_launch: memset of the barrier words failed\n"); return; }
    void* args[] = {&a};
    hipError_t e = hipLaunchCooperativeKernel((const void*)yoco_fwd, dim3(grid), dim3(512), args, LDS_BYTES, stream);
    if (e != hipSuccess) fprintf(stderr, "kernel_launch: cooperative launch failed: %s (grid %d)\n", hipGetErrorString(e), grid);
}
```

```cpp
#include <hip/hip_runtime.h>
#include <hip/hip_cooperative_groups.h>
#include <cstdio>
#include <cmath>
namespace cg = cooperative_groups;

#define LAS __attribute__((address_space(3)))
#define DI __device__ __forceinline__
typedef unsigned short bf16_t;
typedef short bf16x8 __attribute__((ext_vector_type(8)));
typedef short s16x4 __attribute__((ext_vector_type(4)));
typedef float f32x4 __attribute__((ext_vector_type(4)));
typedef float f32x2 __attribute__((ext_vector_type(2)));
typedef unsigned u32x4 __attribute__((ext_vector_type(4)));
typedef unsigned u32x2 __attribute__((ext_vector_type(2)));
typedef __bf16 bfv2 __attribute__((ext_vector_type(2)));

constexpr int T = 16384, SEQ = 8192, DM = 2048;
constexpr float EPS = 1e-6f;
constexpr float QSCALE = 0.08838834764831845f * 1.4426950408889634f;
constexpr float NEGBIG = -1e30f;
constexpr float M_INIT = -30000.0f;

DI unsigned pk_bf16(float a, float b) { f32x2 v = {a, b}; bfv2 r = __builtin_convertvector(v, bfv2); return __builtin_bit_cast(unsigned, r); }
DI float bf_lo(unsigned w) { return __uint_as_float(w << 16); }
DI float bf_hi(unsigned w) { return __uint_as_float(w & 0xffff0000u); }
DI float rstd_of(const float* sumsq, int row) { return rsqrtf(sumsq[row] * (1.0f / 2048.0f) + EPS); }
DI float sigmoidf(float x) { return 1.0f / (1.0f + __expf(-x)); }
DI float xrow_max(float t) {
    { const unsigned u = __float_as_uint(t); const auto r = __builtin_amdgcn_permlane16_swap(u, u, false, false); t = fmaxf(__uint_as_float(r[0]), __uint_as_float(r[1])); }
    { const unsigned u = __float_as_uint(t); const auto r = __builtin_amdgcn_permlane32_swap(u, u, false, false); t = fmaxf(__uint_as_float(r[0]), __uint_as_float(r[1])); }
    return t;
}
DI float xrow_sum(float t) {
    { const unsigned u = __float_as_uint(t); const auto r = __builtin_amdgcn_permlane16_swap(u, u, false, false); t = __uint_as_float(r[0]) + __uint_as_float(r[1]); }
    { const unsigned u = __float_as_uint(t); const auto r = __builtin_amdgcn_permlane32_swap(u, u, false, false); t = __uint_as_float(r[0]) + __uint_as_float(r[1]); }
    return t;
}

constexpr size_t WS_W_IN   = 0;
constexpr size_t WS_W_OUT  = WS_W_IN   + 37748736;
constexpr size_t WS_W_MLP1 = WS_W_OUT  + 4194304;
constexpr size_t WS_W_MLP2 = WS_W_MLP1 + 33554432;
constexpr size_t WS_W_GATE = WS_W_MLP2 + 33554432;
constexpr size_t WS_W_PROJ = WS_W_GATE + 8388608;
constexpr size_t WS_HB     = WS_W_PROJ + 1048576;
constexpr size_t WS_PB     = WS_HB     + 67108864;
constexpr size_t WS_R      = WS_PB     + 16777216;
constexpr size_t WS_OG     = WS_R      + 301989888;
constexpr size_t WS_SUMSQ  = WS_OG     + 100663296;
constexpr size_t WS_ROPE   = WS_SUMSQ  + 7 * 65536;
constexpr size_t WS_LSE    = WS_ROPE   + 1048576;
constexpr size_t WS_CPART  = WS_LSE    + 1572864;
constexpr size_t WS_END    = WS_CPART  + 65536;
constexpr size_t WS_BAR    = WS_END;
constexpr size_t WS_SEL    = WS_LSE;
constexpr size_t W1_KVQG = WS_W_IN, W1_BOUT = W1_KVQG + 22020096, W1_C1K = W1_BOUT + 8388608, W1_C1V = W1_C1K + 2097152, W1_C2K = W1_C1V + 2097152, W1_C2V = W1_C2K + 65536;
constexpr size_t KVSEC = 16777216;
constexpr size_t R_KV = WS_R, R_Q1 = WS_R + 6 * KVSEC, R_GATES = R_Q1 + 67108864, R_PQK = R_GATES + 3145728, R_PQV = R_PQK + 8388608, R_KCMP = R_PQV + 8388608, R_VCMP = R_KCMP + 1048576, R_O1 = R_VCMP + 1048576;

struct Args { const float* in[22]; float* out; unsigned char* ws; float inv_freq[16]; };

namespace pg8 {
#define PG8_LAS __attribute__((address_space(3)))
typedef unsigned short bf16_t;
typedef short bf16x8 __attribute__((ext_vector_type(8)));
typedef float f32x4 __attribute__((ext_vector_type(4)));
typedef unsigned u32x4 __attribute__((ext_vector_type(4)));
constexpr int BM = 256, BK = 64, HALF = 128, HTB = HALF * BK * 2  , STAGE_BYTES = 8 * HTB, NXCD = 8, WGM = 4;

__host__ __device__ __forceinline__ int lds_byte(int r, int c) { const int st = (r >> 4) * 2 + (c >> 5), rr = r & 15, cc = c & 31, ob = rr * 64 + cc * 2; return st * 1024 + (ob ^ (((ob >> 9) & 1) << 5)); }
__host__ __device__ __forceinline__ void stage_rc(int b, int& R, int& C) { const int st = b / 1024, sb = b % 1024, swz = sb ^ (((sb >> 9) & 1) << 5); R = (st >> 1) * 16 + swz / 64; C = (st & 1) * 32 + (swz % 64) / 2; }
__host__ __device__ __forceinline__ int perm32(int rho) { const int n = rho >> 4, i = rho & 15; return 8 * (i >> 2) + 4 * n + (i & 3); }

struct Unit { int pm, pn; };
struct Gemm { const bf16_t* A; const bf16_t* Bt; int M, N, K; };

struct StaticOrder {
    int nM, nN, nwg, G, c;
    __host__ __device__ void init(int M, int N, int G_, int c_) { nM = M / BM; nN = N / BM; nwg = nM * nN; G = G_; c = c_; }
    __host__ __device__ bool next(int i, Unit& u) const {
        const long L = (long)i * G + c; if (L >= nwg) return false;
        int wgid = (int)L; { const int q = nwg / NXCD, r = nwg % NXCD, xcd = wgid % NXCD, off = wgid / NXCD; wgid = (xcd < r ? xcd * (q + 1) : r * (q + 1) + (xcd - r) * q) + off; }
        const int nig = WGM * nN, gid = wgid / nig, fm = gid * WGM, gsz = (nM - fm) < WGM ? (nM - fm) : WGM;
        u.pm = fm + ((wgid % nig) % gsz); u.pn = (wgid % nig) / gsz; return true;
    }
    __device__ __forceinline__ void a_ready(const Unit&) const {}
    __device__ __forceinline__ void done(const Unit&) const {}
};

template <class Epi, class Sched>
__device__ __forceinline__ void gemm_phase(PG8_LAS unsigned char* lds, const Gemm g, const Sched& S, const Epi& E) {
    int tid = threadIdx.x; asm volatile("" : "+v"(tid));
    const int wid = __builtin_amdgcn_readfirstlane(tid >> 6), lane = tid & 63, wr = wid >> 2, wc = wid & 3, fr = lane & 15, fq = lane >> 4;
    const int K = g.K, nt = K / BK;
    unsigned voffA[2], voffB[2];
#pragma unroll
    for (int i = 0; i < 2; ++i) { int R, C; stage_rc(tid * 16 + i * 8192, R, C); const int Rb = Epi::PERM ? ((R & ~31) + perm32(R & 31)) : R;
        voffA[i] = (unsigned)(R * K + C) * 2u; voffB[i] = (unsigned)(Rb * K + C) * 2u; }
    const size_t kstep = (size_t)(BK * 2);
    const size_t hstep = (size_t)HALF * K * 2;
    const size_t tstep = 2 * hstep;
    const unsigned ldsw = (unsigned)wid * 1024u;
    const int aoff = lds_byte(wr * 64 + fr, fq * 8), boff = lds_byte(wc * 32 + fr, fq * 8);
#define PG8_SA(b, h) (((b) * 2 + (h)) * HTB)
#define PG8_SB(b, h) ((4 + (b) * 2 + (h)) * HTB)
#define PG8_STAGE(bufoff, gbase, voff) do { _Pragma("unroll") for (int _i = 0; _i < 2; ++_i) \
        __builtin_amdgcn_global_load_lds((const unsigned*)((const char*)(gbase) + (voff)[_i]), (PG8_LAS unsigned*)(lds + (bufoff) + ldsw + _i * 8192), 16, 0, 0); } while (0)
#define PG8_LDA(dst, b, h) do { _Pragma("unroll") for (int m = 0; m < 4; ++m) _Pragma("unroll") for (int k = 0; k < 2; ++k) dst[m][k] = *(const PG8_LAS bf16x8*)(lds + PG8_SA(b, h) + aoff + m * 2048 + k * 1024); } while (0)
#define PG8_LDB(dst, b, h) do { _Pragma("unroll") for (int n = 0; n < 2; ++n) _Pragma("unroll") for (int k = 0; k < 2; ++k) dst[n][k] = *(const PG8_LAS bf16x8*)(lds + PG8_SB(b, h) + boff + n * 2048 + k * 1024); } while (0)
#define PG8_MMA(ai, bj, At, Bt) do { __builtin_amdgcn_s_setprio(1); _Pragma("unroll") for (int m = 0; m < 4; ++m) _Pragma("unroll") for (int n = 0; n < 2; ++n) _Pragma("unroll") for (int k = 0; k < 2; ++k) \
        acc[ai][bj][m][n] = __builtin_amdgcn_mfma_f32_16x16x32_bf16(Bt[n][k], At[m][k], acc[ai][bj][m][n], 0, 0, 0); __builtin_amdgcn_s_setprio(0); } while (0)
#define PG8_WAIT_V(n) asm volatile("s_waitcnt vmcnt(" #n ")" ::: "memory")
#define PG8_WAIT_L(n) asm volatile("s_waitcnt lgkmcnt(" #n ")" ::: "memory")
#define PG8_BAR __builtin_amdgcn_s_barrier()
#define PG8_SCHED __builtin_amdgcn_sched_barrier(0)
    Unit cur, nxt; int ui = 0;
    if (!S.next(0, cur)) return;
    f32x4 acc[2][2][4][2];
#pragma unroll
    for (int a = 0; a < 2; ++a)
#pragma unroll
        for (int b = 0; b < 2; ++b)
#pragma unroll
            for (int m = 0; m < 4; ++m)
#pragma unroll
                for (int n = 0; n < 2; ++n) acc[a][b][m][n] = (f32x4){0.f, 0.f, 0.f, 0.f};
    bf16x8 At[4][2], B0[2][2], B1[2][2];
    const char* cA = (const char*)g.A + (size_t)cur.pm * tstep; const char* cB = (const char*)g.Bt + (size_t)cur.pn * tstep;
    S.a_ready(cur);
    PG8_STAGE(PG8_SB(0, 0), cB, voffB); PG8_STAGE(PG8_SA(0, 0), cA, voffA); PG8_STAGE(PG8_SB(0, 1), cB + hstep, voffB); PG8_STAGE(PG8_SA(0, 1), cA + hstep, voffA);
    if (wr == 1) PG8_BAR;
    PG8_WAIT_V(4); PG8_BAR;
    PG8_STAGE(PG8_SB(1, 0), cB + kstep, voffB); PG8_STAGE(PG8_SA(1, 0), cA + kstep, voffA); PG8_STAGE(PG8_SB(1, 1), cB + hstep + kstep, voffB);
    PG8_WAIT_V(6); PG8_BAR;
    for (;;) {
        const bool has_next = S.next(ui + 1, nxt);
        const char* nA = has_next ? (const char*)g.A + (size_t)nxt.pm * tstep : cA; const char* nB = has_next ? (const char*)g.Bt + (size_t)nxt.pn * tstep : cB;
        for (int t = 0; t < nt; t += 2) {
            const bool last = (t == nt - 2);
            const char* a1 = cA + (size_t)(t + 1) * kstep;
            const char* a2 = last ? nA : cA + (size_t)(t + 2) * kstep; const char* b2 = last ? nB : cB + (size_t)(t + 2) * kstep;
            const char* a3 = a2 + kstep; const char* b3 = b2 + kstep;
            if (last && has_next) S.a_ready(nxt);
            PG8_LDB(B0, 0, 0); PG8_SCHED; PG8_LDA(At, 0, 0); PG8_STAGE(PG8_SA(1, 1), a1 + hstep, voffA);
            PG8_WAIT_L(8); PG8_BAR; PG8_WAIT_L(0); PG8_MMA(0, 0, At, B0); PG8_BAR; PG8_SCHED;
            PG8_LDB(B1, 0, 1); PG8_STAGE(PG8_SB(0, 0), b2, voffB);
            PG8_BAR; PG8_WAIT_L(0); PG8_MMA(0, 1, At, B1); PG8_BAR;
            PG8_LDA(At, 0, 1); PG8_STAGE(PG8_SA(0, 0), a2, voffA);
            PG8_BAR; PG8_WAIT_L(0); PG8_MMA(1, 0, At, B0); PG8_BAR; PG8_SCHED;
            PG8_STAGE(PG8_SB(0, 1), b2 + hstep, voffB);
            PG8_WAIT_V(6); PG8_BAR; PG8_MMA(1, 1, At, B1); PG8_BAR;
            PG8_LDB(B0, 1, 0); PG8_SCHED; PG8_LDA(At, 1, 0); PG8_STAGE(PG8_SA(0, 1), a2 + hstep, voffA);
            PG8_WAIT_L(8); PG8_BAR; PG8_WAIT_L(0); PG8_MMA(0, 0, At, B0); PG8_BAR; PG8_SCHED;
            PG8_LDB(B1, 1, 1); PG8_STAGE(PG8_SB(1, 0), b3, voffB);
            PG8_BAR; PG8_WAIT_L(0); PG8_MMA(0, 1, At, B1); PG8_BAR;
            PG8_LDA(At, 1, 1); PG8_STAGE(PG8_SA(1, 0), a3, voffA);
            PG8_BAR; PG8_WAIT_L(0); PG8_MMA(1, 0, At, B0); PG8_BAR; PG8_SCHED;
            PG8_STAGE(PG8_SB(1, 1), b3 + hstep, voffB);
            PG8_WAIT_V(6); PG8_BAR; PG8_MMA(1, 1, At, B1); PG8_BAR;
        }
        if constexpr (!Epi::AFTER_DRAIN) { E(acc, cur, wr, wc, fr, fq); S.done(cur); }
        if (!has_next) break;
#pragma unroll
        for (int a = 0; a < 2; ++a)
#pragma unroll
            for (int b = 0; b < 2; ++b)
#pragma unroll
                for (int m = 0; m < 4; ++m)
#pragma unroll
                    for (int n = 0; n < 2; ++n) acc[a][b][m][n] = (f32x4){0.f, 0.f, 0.f, 0.f};
        cur = nxt; cA = nA; cB = nB; ++ui;
    }
    PG8_WAIT_V(0);
    if (wr == 0) PG8_BAR;
    PG8_BAR;
    if constexpr (Epi::AFTER_DRAIN) { E.fused(acc, cur, wr, wc, fr, fq, lds, wid, lane); S.done(cur); }
#undef PG8_SA
#undef PG8_SB
#undef PG8_STAGE
#undef PG8_LDA
#undef PG8_LDB
#undef PG8_MMA
#undef PG8_WAIT_V
#undef PG8_WAIT_L
#undef PG8_BAR
#undef PG8_SCHED
}
}

using pg8::Unit;
DI void rope4(f32x4& v0, f32x4& v1, const f32x4 cs0, const f32x4 cs1) {
    const float c[4] = {cs0[0], cs0[2], cs1[0], cs1[2]}, s[4] = {cs0[1], cs0[3], cs1[1], cs1[3]};
#pragma unroll
    for (int j = 0; j < 4; ++j) { const float x1 = v0[j], x2 = v1[j]; v0[j] = x1 * c[j] - x2 * s[j]; v1[j] = x2 * c[j] + x1 * s[j]; }
}
DI void st_bf4(bf16_t* p, const f32x4 v) { u32x2 w; w.x = pk_bf16(v[0], v[1]); w.y = pk_bf16(v[2], v[3]); *(u32x2*)p = w; }

DI void rstd8(float (&rs)[2][4], const float* sumsq, const Unit& u, int wr, int fr) {
#pragma unroll
    for (int ai = 0; ai < 2; ++ai)
#pragma unroll
        for (int m = 0; m < 4; ++m) rs[ai][m] = sumsq[u.pm * 256 + ai * 128 + wr * 64 + m * 16 + fr];
#pragma unroll
    for (int ai = 0; ai < 2; ++ai)
#pragma unroll
        for (int m = 0; m < 4; ++m) rs[ai][m] = rsqrtf(rs[ai][m] * (1.0f / 2048.0f) + EPS);
}
struct EpiQKV0 {
    static constexpr bool PERM = false, AFTER_DRAIN = false;
    bf16_t* out; const float* sumsq; const float* rope;
    DI void operator()(const f32x4 (&acc)[2][2][4][2], const Unit& u, int wr, int wc, int fr, int fq) const {
        float rsv[2][4]; rstd8(rsv, sumsq, u, wr, fr);
#pragma unroll
        for (int ai = 0; ai < 2; ++ai)
#pragma unroll
            for (int m = 0; m < 4; ++m) {
                const int row = u.pm * 256 + ai * 128 + wr * 64 + m * 16 + fr; const float rs = rsv[ai][m]; const int pos = row & (SEQ - 1);
                f32x4 cs0 = {1.f, 0.f, 1.f, 0.f}, cs1 = {1.f, 0.f, 1.f, 0.f};
                if (wc == 0) { const f32x4* rp = (const f32x4*)(rope + ((size_t)pos * 16 + 4 * fq) * 2); cs0 = rp[0]; cs1 = rp[1]; }
#pragma unroll
                for (int bj = 0; bj < 2; ++bj) {
                    const int colbase = u.pn * 256 + bj * 128; const int sect = colbase / 3072;
                    f32x4 v0 = acc[ai][bj][m][0] * rs, v1 = acc[ai][bj][m][1] * rs;
                    if (wc == 0 && sect < 2) rope4(v0, v1, cs0, cs1);
                    if (sect == 0) { v0 *= QSCALE; v1 *= QSCALE; }
                    bf16_t* p = out + (size_t)row * 9216 + colbase + wc * 32 + 4 * fq;
                    st_bf4(p, v0); st_bf4(p + 16, v1);
                }
            }
    }
};
struct EpiKVQG {
    static constexpr bool PERM = false, AFTER_DRAIN = false;
    bf16_t* kv; bf16_t* q1; float* gates; const float* sumsq; const float* rope;
    DI void operator()(const f32x4 (&acc)[2][2][4][2], const Unit& u, int wr, int wc, int fr, int fq) const {
        float rsv[2][4]; rstd8(rsv, sumsq, u, wr, fr);
#pragma unroll
        for (int ai = 0; ai < 2; ++ai)
#pragma unroll
            for (int m = 0; m < 4; ++m) {
                const int row = u.pm * 256 + ai * 128 + wr * 64 + m * 16 + fr; const float rs = rsv[ai][m]; const int pos = row & (SEQ - 1), b = row >> 13;
                f32x4 cs0 = {1.f, 0.f, 1.f, 0.f}, cs1 = {1.f, 0.f, 1.f, 0.f};
                if (wc == 0) { const f32x4* rp = (const f32x4*)(rope + ((size_t)pos * 16 + 4 * fq) * 2); cs0 = rp[0]; cs1 = rp[1]; }
#pragma unroll
                for (int bj = 0; bj < 2; ++bj) {
                    const int idx = u.pn * 2 + bj;
                    f32x4 v0 = acc[ai][bj][m][0] * rs, v1 = acc[ai][bj][m][1] * rs;
                    if (idx < 24) {
                        const int cb = idx >> 2, g = idx & 3;
                        if (wc == 0 && (cb == 2 || cb == 4)) rope4(v0, v1, cs0, cs1);
                        bf16_t* p = kv + (size_t)cb * (KVSEC / 2) + ((size_t)((b * 4 + g) * SEQ + pos)) * 128 + wc * 32 + 4 * fq;
                        st_bf4(p, v0); st_bf4(p + 16, v1);
                    } else if (idx < 40) {
                        if (wc == 0) rope4(v0, v1, cs0, cs1);
                        v0 *= QSCALE; v1 *= QSCALE;
                        bf16_t* p = q1 + (size_t)row * 2048 + (idx - 24) * 128 + wc * 32 + 4 * fq;
                        st_bf4(p, v0); st_bf4(p + 16, v1);
                    } else if (idx == 40) {
                        const int c0 = wc * 32 + 4 * fq;
                        if (c0 < 48) { f32x4 s; for (int j = 0; j < 4; ++j) s[j] = sigmoidf(v0[j]); *(f32x4*)(gates + (size_t)row * 48 + c0) = s; }
                        if (c0 + 16 < 48) { f32x4 s; for (int j = 0; j < 4; ++j) s[j] = sigmoidf(v1[j]); *(f32x4*)(gates + (size_t)row * 48 + c0 + 16) = s; }
                    }
                }
            }
    }
};
struct EpiRes {
    static constexpr bool PERM = false, AFTER_DRAIN = false;
    const float* base; float* h; bf16_t* hb; float* sumsq;
    DI void operator()(const f32x4 (&acc)[2][2][4][2], const Unit& u, int wr, int wc, int fr, int fq) const {
#pragma unroll
        for (int ai = 0; ai < 2; ++ai)
#pragma unroll
            for (int m = 0; m < 4; ++m) {
                const int row = u.pm * 256 + ai * 128 + wr * 64 + m * 16 + fr; float ss = 0.f;
                const size_t off = (size_t)row * 2048 + u.pn * 256 + wc * 32 + 4 * fq;
#pragma unroll
                for (int bj = 0; bj < 2; ++bj)
#pragma unroll
                    for (int n = 0; n < 2; ++n) {
                        const size_t o = off + bj * 128 + n * 16;
                        const f32x4 v = acc[ai][bj][m][n] + *(const f32x4*)(base + o);
                        *(f32x4*)(h + o) = v; st_bf4(hb + o, v);
                        ss += (v[0] * v[0] + v[1] * v[1]) + (v[2] * v[2] + v[3] * v[3]);
                    }
                ss = xrow_sum(ss);
                if (fq == 0) atomicAdd(sumsq + row, ss);
                asm volatile("" ::: "memory");
            }
    }
};
struct EpiRelu2 {
    static constexpr bool PERM = true, AFTER_DRAIN = false;
    bf16_t* out; const float* sumsq;
    DI void operator()(const f32x4 (&acc)[2][2][4][2], const Unit& u, int wr, int wc, int fr, int fq) const {
        float rsv[2][4]; rstd8(rsv, sumsq, u, wr, fr);
#pragma unroll
        for (int ai = 0; ai < 2; ++ai)
#pragma unroll
            for (int m = 0; m < 4; ++m) {
                const int row = u.pm * 256 + ai * 128 + wr * 64 + m * 16 + fr; const float rs = rsv[ai][m];
                bf16_t* rowp = out + (size_t)row * 8192 + u.pn * 256 + wc * 32 + 8 * fq;
#pragma unroll
                for (int bj = 0; bj < 2; ++bj) {
                    f32x4 v0 = acc[ai][bj][m][0] * rs, v1 = acc[ai][bj][m][1] * rs;
#pragma unroll
                    for (int j = 0; j < 4; ++j) { v0[j] = fmaxf(v0[j], 0.f); v0[j] *= v0[j]; v1[j] = fmaxf(v1[j], 0.f); v1[j] *= v1[j]; }
                    u32x4 w; w.x = pk_bf16(v0[0], v0[1]); w.y = pk_bf16(v0[2], v0[3]); w.z = pk_bf16(v1[0], v1[1]); w.w = pk_bf16(v1[2], v1[3]);
                    *(u32x4*)(rowp + bj * 128) = w;
                }
            }
    }
};
struct EpiBf {
    static constexpr bool PERM = false, AFTER_DRAIN = false;
    bf16_t* out; int ldc;
    DI void operator()(const f32x4 (&acc)[2][2][4][2], const Unit& u, int wr, int wc, int fr, int fq) const {
#pragma unroll
        for (int ai = 0; ai < 2; ++ai)
#pragma unroll
            for (int m = 0; m < 4; ++m) {
                const int row = u.pm * 256 + ai * 128 + wr * 64 + m * 16 + fr;
                bf16_t* rowp = out + (size_t)row * ldc + u.pn * 256 + wc * 32 + 4 * fq;
#pragma unroll
                for (int bj = 0; bj < 2; ++bj)
#pragma unroll
                    for (int n = 0; n < 2; ++n) st_bf4(rowp + bj * 128 + n * 16, acc[ai][bj][m][n]);
            }
    }
};
struct EpiF32 {
    static constexpr bool PERM = false, AFTER_DRAIN = false;
    float* out; int ldc;
    DI void operator()(const f32x4 (&acc)[2][2][4][2], const Unit& u, int wr, int wc, int fr, int fq) const {
#pragma unroll
        for (int ai = 0; ai < 2; ++ai)
#pragma unroll
            for (int m = 0; m < 4; ++m) {
                const int row = u.pm * 256 + ai * 128 + wr * 64 + m * 16 + fr;
                float* rowp = out + (size_t)row * ldc + u.pn * 256 + wc * 32 + 4 * fq;
#pragma unroll
                for (int bj = 0; bj < 2; ++bj)
#pragma unroll
                    for (int n = 0; n < 2; ++n) *(f32x4*)(rowp + bj * 128 + n * 16) = acc[ai][bj][m][n];
            }
    }
};
struct EpiGate {
    static constexpr bool PERM = false, AFTER_DRAIN = false;
    float* h; bf16_t* hb; const bf16_t* proj; const float* sumsq_in; float* sumsq_out;
    DI void operator()(const f32x4 (&acc)[2][2][4][2], const Unit& u, int wr, int wc, int fr, int fq) const {
        float rsv[2][4]; rstd8(rsv, sumsq_in, u, wr, fr);
#pragma unroll
        for (int ai = 0; ai < 2; ++ai)
#pragma unroll
            for (int m = 0; m < 4; ++m) {
                const int row = u.pm * 256 + ai * 128 + wr * 64 + m * 16 + fr; const float rs = rsv[ai][m]; float ss = 0.f;
                const size_t off = (size_t)row * 2048 + u.pn * 256 + wc * 32 + 4 * fq;
#pragma unroll
                for (int bj = 0; bj < 2; ++bj)
#pragma unroll
                    for (int n = 0; n < 2; ++n) {
                        const size_t o = off + bj * 128 + n * 16;
                        const u32x2 pw = *(const u32x2*)(proj + o); const f32x4 hv = *(const f32x4*)(h + o); const f32x4 a = acc[ai][bj][m][n] * rs;
                        f32x4 v;
                        v[0] = hv[0] + bf_lo(pw.x) * sigmoidf(a[0]); v[1] = hv[1] + bf_hi(pw.x) * sigmoidf(a[1]);
                        v[2] = hv[2] + bf_lo(pw.y) * sigmoidf(a[2]); v[3] = hv[3] + bf_hi(pw.y) * sigmoidf(a[3]);
                        *(f32x4*)(h + o) = v; st_bf4(hb + o, v);
                        ss += (v[0] * v[0] + v[1] * v[1]) + (v[2] * v[2] + v[3] * v[3]);
                    }
                ss = xrow_sum(ss);
                if (fq == 0) atomicAdd(sumsq_out + row, ss);
                asm volatile("" ::: "memory");
            }
    }
};
DI void convert_T(const float* src, int K, int N, int ld, const float* g, bf16_t* dst, int pitch, LAS float* tile, int blk, int nblk) {
    int tid = threadIdx.x; asm volatile("" : "+v"(tid));
    const int ntn = (N + 63) >> 6, ntk = K >> 6, tr = tid >> 3, tc = (tid & 7) * 8;
    for (int t = blk; t < ntn * ntk; t += nblk) {
        const int tk = t / ntn, tn = t - tk * ntn;
        const int k = tk * 64 + tr, n0 = tn * 64 + tc;
        const float gg = g ? g[k] : 1.0f;
        f32x4 a = {0.f, 0.f, 0.f, 0.f}, b = {0.f, 0.f, 0.f, 0.f};
        if (n0 < N) a = *(const f32x4*)(src + (size_t)k * ld + n0);
        if (n0 + 4 < N) b = *(const f32x4*)(src + (size_t)k * ld + n0 + 4);
#pragma unroll
        for (int j = 0; j < 4; ++j) { tile[tr * 65 + tc + j] = a[j] * gg; tile[tr * 65 + tc + 4 + j] = b[j] * gg; }
        __syncthreads();
        const int n = tn * 64 + tr;
        if (n < N) {
            float v[8];
#pragma unroll
            for (int j = 0; j < 8; ++j) v[j] = tile[(tc + j) * 65 + tr];
            u32x4 w; w.x = pk_bf16(v[0], v[1]); w.y = pk_bf16(v[2], v[3]); w.z = pk_bf16(v[4], v[5]); w.w = pk_bf16(v[6], v[7]);
            *(u32x4*)(dst + (size_t)n * pitch + tk * 64 + tc) = w;
        }
        __syncthreads();
    }
}
DI void convert_layer_mlp(const Args& a, int layer, LAS float* tile) {
    unsigned char* ws = a.ws; const int blk = blockIdx.x, nblk = gridDim.x;
    convert_T(a.in[16] + (size_t)layer * 2048 * 8192, 2048, 8192, 8192, a.in[15] + layer * 2048, (bf16_t*)(ws + WS_W_MLP1), 2048, tile, blk, nblk);
    convert_T(a.in[17] + (size_t)layer * 8192 * 2048, 8192, 2048, 2048, nullptr, (bf16_t*)(ws + WS_W_MLP2), 8192, tile, blk, nblk);
}
DI void convert_layer_ple(const Args& a, int layer, LAS float* tile) {
    unsigned char* ws = a.ws; const int blk = blockIdx.x, nblk = gridDim.x;
    convert_T(a.in[19] + (size_t)layer * 2048 * 2048, 2048, 2048, 2048, a.in[18] + layer * 2048, (bf16_t*)(ws + WS_W_GATE), 2048, tile, blk, nblk);
    convert_T(a.in[20] + (size_t)layer * 256 * 2048, 256, 2048, 2048, nullptr, (bf16_t*)(ws + WS_W_PROJ), 256, tile, blk, nblk);
}
DI void convert_layer1_attn(const Args& a, LAS float* tile) {
    unsigned char* ws = a.ws; const int blk = blockIdx.x, nblk = gridDim.x;
    bf16_t* kvqg = (bf16_t*)(ws + W1_KVQG);
    convert_T(a.in[7], 2048, 3072, 3072, a.in[6], kvqg, 2048, tile, blk, nblk);
    convert_T(a.in[4], 2048, 2096, 2096, a.in[14] + 2048, kvqg + (size_t)3072 * 2048, 2048, tile, blk, nblk);
    { u32x4 z = {0u, 0u, 0u, 0u}; u32x4* p = (u32x4*)(kvqg + (size_t)5168 * 2048);
      for (int i = blk * 512 + (int)threadIdx.x; i < 208 * 2048 / 8; i += nblk * 512) p[i] = z; }
    convert_T(a.in[5], 2048, 2048, 2048, nullptr, (bf16_t*)(ws + W1_BOUT), 2048, tile, blk, nblk);
    convert_T(a.in[9], 2048, 256, 256, nullptr, (bf16_t*)(ws + W1_C1K), 2048, tile, blk, nblk);
    convert_T(a.in[9] + 2048 * 256, 2048, 256, 256, nullptr, (bf16_t*)(ws + W1_C1K) + (size_t)256 * 2048, 2048, tile, blk, nblk);
    convert_T(a.in[12], 2048, 256, 256, nullptr, (bf16_t*)(ws + W1_C1V), 2048, tile, blk, nblk);
    convert_T(a.in[12] + 2048 * 256, 2048, 256, 256, nullptr, (bf16_t*)(ws + W1_C1V) + (size_t)256 * 2048, 2048, tile, blk, nblk);
    convert_T(a.in[10], 256, 128, 128, nullptr, (bf16_t*)(ws + W1_C2K), 256, tile, blk, nblk);
    convert_T(a.in[13], 256, 128, 128, nullptr, (bf16_t*)(ws + W1_C2V), 256, tile, blk, nblk);
}
DI void phase_prologue(const Args& a, LAS unsigned char* lds) {
    unsigned char* ws = a.ws; int tid = threadIdx.x; asm volatile("" : "+v"(tid)); const int blk = blockIdx.x, nblk = gridDim.x, lane = tid & 63, wid = tid >> 6;
    const size_t gtid = (size_t)blk * 512 + tid, nthr = (size_t)nblk * 512;
    { const float* x = a.in[0]; bf16_t* hb = (bf16_t*)(ws + WS_HB); float* ss0 = (float*)(ws + WS_SUMSQ);
      for (int row = blk * 8 + wid; row < T; row += nblk * 8) {
          float ss = 0.f;
#pragma unroll
          for (int i = 0; i < 8; ++i) { const int c = (i * 64 + lane) * 4; const f32x4 v = *(const f32x4*)(x + (size_t)row * 2048 + c);
              ss += (v[0] * v[0] + v[1] * v[1]) + (v[2] * v[2] + v[3] * v[3]); st_bf4(hb + (size_t)row * 2048 + c, v); }
#pragma unroll
          for (int o = 1; o < 64; o <<= 1) ss += __shfl_xor(ss, o);
          if (lane == 0) ss0[row] = ss;
      } }
    { float* s = (float*)(ws + WS_SUMSQ) + T; for (size_t i = gtid; i < (size_t)6 * T; i += nthr) s[i] = 0.f; }
    { const float* p = a.in[1]; bf16_t* pb = (bf16_t*)(ws + WS_PB);
      for (size_t i = gtid; i < (size_t)2 * T * 256 / 8; i += nthr) { const f32x4 v0 = *(const f32x4*)(p + i * 8), v1 = *(const f32x4*)(p + i * 8 + 4);
          u32x4 w; w.x = pk_bf16(v0[0], v0[1]); w.y = pk_bf16(v0[2], v0[3]); w.z = pk_bf16(v1[0], v1[1]); w.w = pk_bf16(v1[2], v1[3]); *(u32x4*)(pb + i * 8) = w; } }
    { float* rope = (float*)(ws + WS_ROPE);
      for (size_t i = gtid; i < (size_t)SEQ * 16; i += nthr) { const int pos = (int)(i >> 4), fi = (int)(i & 15); const float ang = (float)pos * a.inv_freq[fi];
          double rv = (double)ang * 0.15915494309189535; rv -= floor(rv); const float fr = (float)rv;
          rope[i * 2] = __builtin_amdgcn_cosf(fr); rope[i * 2 + 1] = __builtin_amdgcn_sinf(fr); } }
    if (blk < 32) { const int job = blk * 2 + (tid >> 8), kv = job >> 5, l = job & 31, col = tid & 255;
        const float* pe = a.in[kv ? 11 : 8] + l * 128; const float* w1 = a.in[kv ? 12 : 9] + (size_t)l * 128 * 256 + col; float s = 0.f;
#pragma unroll 8
        for (int d = 0; d < 128; ++d) s += pe[d] * w1[(size_t)d * 256];
        ((float*)(ws + WS_CPART))[job * 256 + col] = s; }
    LAS float* tile = (LAS float*)lds;
    convert_T(a.in[2], 2048, 9216, 9216, a.in[14], (bf16_t*)(ws + WS_W_IN), 2048, tile, blk, nblk);
    convert_T(a.in[3], 1024, 2048, 2048, nullptr, (bf16_t*)(ws + WS_W_OUT), 1024, tile, blk, nblk);
    convert_layer_mlp(a, 0, tile);
    convert_layer_ple(a, 0, tile);
}
constexpr int KV_PITCH = 288, V_PITCH = 288, KV_TILE = 64 * KV_PITCH, V_TILE = 64 * V_PITCH, KV_BUF = KV_TILE + V_TILE, ATT_WAVE_OFF = 2 * KV_BUF, ATT_WAVE_BYTES = 2304;
#define MFMA16(a, b, c) __builtin_amdgcn_mfma_f32_16x16x32_bf16((a), (b), (c), 0, 0, 0)
struct StageRegs { u32x4 k[2], v[2]; };
template <bool LOADV> DI void stage_issue(StageRegs& r, const bf16_t* kb, const bf16_t* vb, size_t pitch, int tid) {
#pragma unroll
    for (int i = 0; i < 2; ++i) { const int c = tid + 512 * i, row = c >> 4, ch = c & 15;
        r.k[i] = *(const u32x4*)(kb + (size_t)row * pitch + ch * 8);
        if (LOADV) r.v[i] = *(const u32x4*)(vb + (size_t)row * pitch + ch * 8); }
}
template <bool LOADV> DI void stage_write(LAS unsigned char* kl, const StageRegs& r, int tid) {
#pragma unroll
    for (int i = 0; i < 2; ++i) { const int c = tid + 512 * i, row = c >> 4, ch = c & 15;
        *(LAS u32x4*)(kl + row * KV_PITCH + ch * 16) = r.k[i];
        if (LOADV) *(LAS u32x4*)(kl + KV_TILE + row * V_PITCH + ch * 16) = r.v[i]; }
}
template <bool LOADV, class F> DI void tile_loop(const bf16_t* kb, const bf16_t* vb, size_t pitch, int ntiles, LAS unsigned char* lds, int tid, const F& f) {
    if (ntiles <= 0) return;
    StageRegs sr;
    stage_issue<LOADV>(sr, kb, vb, pitch, tid);
    stage_write<LOADV>(lds, sr, tid);
    __syncthreads();
    for (int i = 0; i < ntiles; ++i) {
        LAS unsigned char* kl = lds + (i & 1) * KV_BUF;
        if (i + 1 < ntiles) stage_issue<LOADV>(sr, kb + (size_t)(i + 1) * 64 * pitch, vb + (size_t)(i + 1) * 64 * pitch, pitch, tid);
        f(i, kl, kl + KV_TILE);
        if (i + 1 < ntiles) stage_write<LOADV>(lds + ((i + 1) & 1) * KV_BUF, sr, tid);
        __syncthreads();
    }
}
DI float quad_sum(float v) {
    v += __uint_as_float((unsigned)__builtin_amdgcn_update_dpp(0, (int)__float_as_uint(v), 0xB1, 0xF, 0xF, true));
    v += __uint_as_float((unsigned)__builtin_amdgcn_update_dpp(0, (int)__float_as_uint(v), 0x4E, 0xF, 0xF, true));
    return v;
}
struct AttnAcc { f32x4 o[8]; f32x4 ls; float m, l; };
DI void acc_reset(AttnAcc& a) {
#pragma unroll
    for (int n = 0; n < 8; ++n) a.o[n] = (f32x4){0.f, 0.f, 0.f, 0.f};
    a.m = M_INIT; a.l = 0.f; a.ls = (f32x4){0.f, 0.f, 0.f, 0.f};
}
template <int MODE, class MaskF, class PF>
DI void attn_tile(LAS const unsigned char* kl, LAS const unsigned char* vl, const bf16x8 (&qf)[4], AttnAcc& A, float inv_l, bool allkeys, bool lane_ok, const MaskF& valid, const PF& pf, int lane) {
    const int r16 = lane & 15, g4 = lane >> 4;
    f32x4 s[4];
#pragma unroll
    for (int kt = 0; kt < 4; ++kt) { s[kt] = (f32x4){0.f, 0.f, 0.f, 0.f};
#pragma unroll
        for (int ks = 0; ks < 4; ++ks) { const bf16x8 kf = *(LAS const bf16x8*)(kl + (16 * kt + r16) * KV_PITCH + ks * 64 + g4 * 16); s[kt] = MFMA16(kf, qf[ks], s[kt]); } }
    float tmax = NEGBIG;
    if (__builtin_amdgcn_readfirstlane((int)allkeys)) {
#pragma unroll
        for (int kt = 0; kt < 4; ++kt) tmax = fmaxf(tmax, fmaxf(fmaxf(s[kt][0], s[kt][1]), fmaxf(s[kt][2], s[kt][3])));
        tmax = lane_ok ? tmax : NEGBIG;
    } else {
#pragma unroll
        for (int kt = 0; kt < 4; ++kt)
#pragma unroll
            for (int i = 0; i < 4; ++i) { const bool ok = lane_ok && valid(16 * kt + 4 * g4 + i); const float sv = ok ? s[kt][i] : NEGBIG; s[kt][i] = sv; tmax = fmaxf(tmax, sv); }
    }
    float mref = A.m;
    if (MODE != 2) {
        if (__any(tmax > A.m + 16.0f)) {
            tmax = xrow_max(tmax);
            const float mn = fmaxf(A.m, tmax), alpha = __builtin_amdgcn_exp2f(A.m - mn);
            A.m = mn;
            if (MODE == 1) A.l *= alpha;
            if (MODE == 0) { A.ls *= alpha;
#pragma unroll
                for (int n = 0; n < 8; ++n) A.o[n] *= alpha; }
        }
        mref = A.m;
    }
    mref = lane_ok ? mref : 1e30f;
    float psum = 0.f;
#pragma unroll
    for (int kt = 0; kt < 4; ++kt)
#pragma unroll
        for (int i = 0; i < 4; ++i) { float p = __builtin_amdgcn_exp2f(s[kt][i] - mref); if (MODE == 2) p *= inv_l; s[kt][i] = p; psum += p; }
    if (MODE == 1) A.l += psum;
    if (MODE == 1) return;
    if (MODE == 2) {
#pragma unroll
        for (int kt = 0; kt < 4; ++kt) pf(kt, s[kt]); }
    const int q = r16 >> 2, pp = r16 & 3;
    LAS const unsigned char* vb = vl + (4 * g4 + q) * V_PITCH + pp * 8;
#pragma unroll
    for (int kk = 0; kk < 2; ++kk) {
        u32x4 pw; pw.x = pk_bf16(s[2 * kk][0], s[2 * kk][1]); pw.y = pk_bf16(s[2 * kk][2], s[2 * kk][3]); pw.z = pk_bf16(s[2 * kk + 1][0], s[2 * kk + 1][1]); pw.w = pk_bf16(s[2 * kk + 1][2], s[2 * kk + 1][3]);
        const bf16x8 pfrag = __builtin_bit_cast(bf16x8, pw);
        if (MODE == 0) { const bf16x8 ones = {0x3F80, 0x3F80, 0x3F80, 0x3F80, 0x3F80, 0x3F80, 0x3F80, 0x3F80}; A.ls = MFMA16(ones, pfrag, A.ls); }
#pragma unroll
        for (int n = 0; n < 8; ++n) {
            const s16x4 lo = __builtin_amdgcn_ds_read_tr16_b64_v4i16((LAS s16x4*)(vb + (32 * kk) * V_PITCH + n * 32));
            const s16x4 hi = __builtin_amdgcn_ds_read_tr16_b64_v4i16((LAS s16x4*)(vb + (32 * kk + 16) * V_PITCH + n * 32));
            const bf16x8 vf = __builtin_shufflevector(lo, hi, 0, 1, 2, 3, 4, 5, 6, 7);
            A.o[n] = MFMA16(vf, pfrag, A.o[n]);
        }
    }
}
struct NoPF { DI void operator()(int, const f32x4&) const {} };
DI void load_qf(bf16x8 (&qf)[4], const bf16_t* qrow, int g4) {
#pragma unroll
    for (int ks = 0; ks < 4; ++ks) qf[ks] = *(const bf16x8*)(qrow + ks * 32 + g4 * 8);
}

DI void phase_dilated(const bf16_t* qkv, bf16_t* og, float* lse, LAS unsigned char* lds) {
    int tid = threadIdx.x; asm volatile("" : "+v"(tid)); const int lane = tid & 63, wid = tid >> 6, r16 = lane & 15, g4 = lane >> 4;
    for (int it0 = blockIdx.x; it0 < 3072; it0 += gridDim.x) {
        const int it = (it0 & ~255) | ((it0 & 7) << 5) | ((it0 >> 3) & 31);
        const int b = it / 1536, rem = it - b * 1536, hh = rem >> 6, w = rem & 63, g = hh >> 3, dsh = 2 * g, dil = 1 << dsh, r = w >> (6 - dsh), tile = w & ((64 >> dsh) - 1);
        const int i0 = tile * 128;
        const bf16_t* qbase = qkv + (size_t)(b * SEQ + r) * 9216 + hh * 128;
        const size_t pitch = (size_t)dil * 9216;
        const int iq = i0 + wid * 16 + r16;
        bf16x8 qf[4]; load_qf(qf, qbase + (size_t)iq * pitch, g4);
        AttnAcc A; acc_reset(A);
        const int kt0 = (i0 == 0) ? 2 : 0;
        const int j0 = i0 - 128 + 64 * kt0;
        tile_loop<true>(qbase + 3072 + (size_t)j0 * pitch, qbase + 6144 + (size_t)j0 * pitch, pitch, 4 - kt0, lds, tid, [&](int i, LAS unsigned char* kl, LAS unsigned char* vl) {
            const int rel0 = 64 * (kt0 + i);
            if (rel0 <= 16 * wid + 143 && rel0 + 63 >= 16 * wid) {
                const int jb = i0 - 128 + rel0;
                const int iqlo = i0 + wid * 16;
                attn_tile<0>(kl, vl, qf, A, 0.f, jb + 63 <= iqlo && jb >= iqlo + 15 - 128, true, [&](int off) { const int d = iq - (jb + off); return d >= 0 && d <= 128; }, NoPF(), lane);
            }
        });
        const float l = A.ls[0];
        const float inv = 1.0f / l;
        const size_t row = (size_t)b * SEQ + r + (size_t)dil * iq;
        bf16_t* op = og + row * 3072 + hh * 128 + 4 * g4;
#pragma unroll
        for (int n = 0; n < 8; ++n) st_bf4(op + 16 * n, A.o[n] * inv);
        if (g4 == 0) lse[row * 24 + hh] = A.m + __builtin_amdgcn_logf(l);
    }
}
DI void phase_combine(const bf16_t* og, const float* lse, bf16_t* o0) {
    int tid_ = threadIdx.x; asm volatile("" : "+v"(tid_)); const size_t gtid = (size_t)blockIdx.x * 512 + tid_, nthr = (size_t)gridDim.x * 512;
    for (size_t idx = gtid; idx < (size_t)T * 128; idx += nthr) {
        const size_t row = idx >> 7; const int c = (int)(idx & 127), h = c >> 4, d8 = (c & 15) * 8;
        const float l0 = lse[row * 24 + h], l1 = lse[row * 24 + 8 + h], l2 = lse[row * 24 + 16 + h];
        const float mx = fmaxf(l0, fmaxf(l1, l2));
        float w0 = __builtin_amdgcn_exp2f(l0 - mx), w1 = __builtin_amdgcn_exp2f(l1 - mx), w2 = __builtin_amdgcn_exp2f(l2 - mx);
        const float inv = 1.0f / (w0 + w1 + w2); w0 *= inv; w1 *= inv; w2 *= inv;
        const u32x4 a = *(const u32x4*)(og + row * 3072 + h * 128 + d8), b = *(const u32x4*)(og + row * 3072 + (8 + h) * 128 + d8), c2 = *(const u32x4*)(og + row * 3072 + (16 + h) * 128 + d8);
        u32x4 o;
#pragma unroll
        for (int j = 0; j < 4; ++j) o[j] = pk_bf16(w0 * bf_lo(a[j]) + w1 * bf_lo(b[j]) + w2 * bf_lo(c2[j]), w0 * bf_hi(a[j]) + w1 * bf_hi(b[j]) + w2 * bf_hi(c2[j]));
        *(u32x4*)(o0 + row * 1024 + h * 128 + d8) = o;
    }
}
DI float gelu_tanh(float x) { const float y = 0.7978845608028654f * (x + 0.044715f * x * x * x); const float e = __expf(2.0f * y); return 0.5f * x * (2.0f - 2.0f / (1.0f + e)); }
DI void phase_cmp2(const Args& a, LAS unsigned char* lds) {
    unsigned char* ws = a.ws; int tid = threadIdx.x; asm volatile("" : "+v"(tid)); const int lane = tid & 63, wid = tid >> 6, r16 = lane & 15, g4 = lane >> 4;
    LAS float* cvec = (LAS float*)lds;
    { const float* cp = (const float*)(ws + WS_CPART) + (tid >> 8) * 32 * 256 + (tid & 255); float s = 0.f;
      for (int l = 0; l < 32; ++l) s += cp[l * 256];
      cvec[tid] = s; }
    __syncthreads();
    const float* rope = (const float*)(ws + WS_ROPE);
    for (int wi = blockIdx.x * 8 + wid; wi < 512; wi += gridDim.x * 8) {
        const int kv = wi >> 8, bg = (wi >> 5) & 7, n0 = (wi & 31) * 16;
        const float* PQ = (const float*)(ws + (kv ? R_PQV : R_PQK)); const bf16_t* w2t = (const bf16_t*)(ws + (kv ? W1_C2V : W1_C2K));
        bf16_t* dst = (bf16_t*)(ws + (kv ? R_VCMP : R_KCMP));
        const int n = n0 + r16, n1 = n + 1 < 512 ? n + 1 : 511;
        const float* Pp = PQ + (size_t)(bg * 512 + n) * 512; const float* Qp = PQ + (size_t)(bg * 512 + n1) * 512 + 256;
        f32x4 acc[8];
#pragma unroll
        for (int nt = 0; nt < 8; ++nt) acc[nt] = (f32x4){0.f, 0.f, 0.f, 0.f};
#pragma unroll
        for (int ks = 0; ks < 8; ++ks) {
            const int k0 = ks * 32 + g4 * 8;
            const f32x4 p0 = *(const f32x4*)(Pp + k0), p1 = *(const f32x4*)(Pp + k0 + 4), q0 = *(const f32x4*)(Qp + k0), q1 = *(const f32x4*)(Qp + k0 + 4);
            float hv[8];
#pragma unroll
            for (int j = 0; j < 4; ++j) { hv[j] = gelu_tanh(p0[j] + q0[j] + cvec[kv * 256 + k0 + j]); hv[4 + j] = gelu_tanh(p1[j] + q1[j] + cvec[kv * 256 + k0 + 4 + j]); }
            u32x4 aw; aw.x = pk_bf16(hv[0], hv[1]); aw.y = pk_bf16(hv[2], hv[3]); aw.z = pk_bf16(hv[4], hv[5]); aw.w = pk_bf16(hv[6], hv[7]);
            const bf16x8 af = __builtin_bit_cast(bf16x8, aw);
#pragma unroll
            for (int nt = 0; nt < 8; ++nt) { const bf16x8 bfr = *(const bf16x8*)(w2t + (size_t)(16 * nt + r16) * 256 + k0); acc[nt] = MFMA16(af, bfr, acc[nt]); }
        }
#pragma unroll
        for (int i = 0; i < 4; ++i) {
            const int nn = n0 + 4 * g4 + i;
            if (kv == 0) { const int pos = 16 * nn + 31; const f32x2 cs = *(const f32x2*)(rope + ((size_t)(pos & (SEQ - 1)) * 16 + r16) * 2);
                const float x1 = acc[0][i], x2 = acc[1][i]; acc[0][i] = x1 * cs.x - x2 * cs.y; acc[1][i] = x2 * cs.x + x1 * cs.y; }
#pragma unroll
            for (int nt = 0; nt < 8; ++nt) { const float v = nn < 511 ? acc[nt][i] : 0.f; dst[(size_t)(bg * 512 + nn) * 128 + 16 * nt + r16] = (bf16_t)(pk_bf16(v, 0.f) & 0xffffu); }
        }
    }
}
DI void phase_nsa(const Args& a, LAS unsigned char* lds) {
    unsigned char* ws = a.ws; int tid0 = threadIdx.x;
    const bf16_t* q1 = (const bf16_t*)(ws + R_Q1); const float* gates = (const float*)(ws + R_GATES); bf16_t* o1 = (bf16_t*)(ws + R_O1);
    for (int it = blockIdx.x; it < 2048; it += gridDim.x) {
        int tid = tid0; asm volatile("" : "+v"(tid));
        const int lane = tid & 63, wid = tid >> 6, r16 = lane & 15, g4 = lane >> 4, qi = r16 >> 2, hh = r16 & 3;
        LAS float* imp = (LAS float*)(lds + ATT_WAVE_OFF + wid * ATT_WAVE_BYTES);
        LAS unsigned long long* selm = (LAS unsigned long long*)(lds + ATT_WAVE_OFF + wid * ATT_WAVE_BYTES + 2048);
        const int k8 = it >> 8, jr = it & 255, jj = ((jr & 7) << 5) | (jr >> 3), tile = (k8 & 1) ? 255 - jj : jj, b = k8 >> 2, g = k8 & 3, bg = b * 4 + g;
        const int t0 = tile * 32, tq = t0 + wid * 4 + qi; const size_t row = (size_t)b * SEQ + tq;
        bf16x8 qf[4]; load_qf(qf, q1 + row * 2048 + (g * 4 + hh) * 128, g4);
        const bf16_t* kc = (const bf16_t*)(ws + R_KCMP) + (size_t)bg * 512 * 128; const bf16_t* vc = (const bf16_t*)(ws + R_VCMP) + (size_t)bg * 512 * 128;
        const bf16_t* ksl = (const bf16_t*)(ws + R_KV + 2 * KVSEC) + (size_t)bg * SEQ * 128; const bf16_t* vsl = (const bf16_t*)(ws + R_KV + 3 * KVSEC) + (size_t)bg * SEQ * 128;
        const bf16_t* kwn = (const bf16_t*)(ws + R_KV + 4 * KVSEC) + (size_t)bg * SEQ * 128; const bf16_t* vwn = (const bf16_t*)(ws + R_KV + 5 * KVSEC) + (size_t)bg * SEQ * 128;
        const float gt0 = gates[row * 48 + g * 4 + hh], gt1 = gates[row * 48 + 16 + g * 4 + hh], gt2 = gates[row * 48 + 32 + g * 4 + hh];
        const int ncv = tq >= 31 ? ((tq - 31) >> 4) + 1 : 0;
        const int ntc = ((t0 >> 4) + 1 + 63) >> 6;
        const int tq_min = t0 + wid * 4, ncv_min = tq_min >= 31 ? ((tq_min - 31) >> 4) + 1 : 0;
#pragma unroll
        for (int i = 0; i < 8; ++i) imp[i * 64 + lane] = 0.f;
        AttnAcc A; acc_reset(A);
        tile_loop<false>(kc, vc, 128, ntc, lds, tid, [&](int i, LAS unsigned char* kl, LAS unsigned char* vl) {
            attn_tile<1>(kl, vl, qf, A, 0.f, 64 * i + 64 <= ncv_min, true, [&](int off) { return 64 * i + off < ncv; }, NoPF(), lane); });
        float lc = A.l; lc = xrow_sum(lc);
        const float inv_lc = lc > 0.f ? 1.0f / lc : 0.f;
        tile_loop<true>(kc, vc, 128, ntc, lds, tid, [&](int i, LAS unsigned char* kl, LAS unsigned char* vl) {
            attn_tile<2>(kl, vl, qf, A, inv_lc, 64 * i + 64 <= ncv_min, true, [&](int off) { return 64 * i + off < ncv; },
                [&](int kt, const f32x4& p) {
                    float mainv = (p[0] + p[1]) + (p[2] + 0.5f * p[3]), halfv = 0.5f * p[3];
                    mainv = quad_sum(mainv); halfv = quad_sum(halfv);
                    const int j = 16 * i + 4 * kt + g4;
                    asm volatile("" ::: "memory");
                    if (hh == 0) imp[qi * 128 + j] += mainv;
                    asm volatile("" ::: "memory");
                    if (hh == 0 && j + 1 < 128) imp[qi * 128 + j + 1] += halfv;
                    asm volatile("" ::: "memory");
                }, lane); });
        u32x2 totp[8];
#pragma unroll
        for (int n = 0; n < 8; ++n) { const f32x4 v = A.o[n] * gt0; totp[n].x = pk_bf16(v[0], v[1]); totp[n].y = pk_bf16(v[2], v[3]); }
        const int cur = t0 >> 6;
#pragma unroll 1
        for (int qq = 0; qq < 4; ++qq) {
            const float s0 = imp[qq * 128 + lane], s1 = imp[qq * 128 + 64 + lane];
            const int ja = lane, jb = lane + 64;
            const unsigned b0 = (ja == 0 || ja == cur || ja == cur - 1) ? 0x4E6E6B28u : __float_as_uint(s0);
            const unsigned b1 = (jb == cur || jb == cur - 1) ? 0x4E6E6B28u : __float_as_uint(s1);
            const unsigned long long k0 = ja <= cur ? ((((unsigned long long)b0) << 7) | (unsigned long long)(127 - ja)) + 1ull : 0ull;
            const unsigned long long k1 = jb <= cur ? ((((unsigned long long)b1) << 7) | (unsigned long long)(127 - jb)) + 1ull : 0ull;
            unsigned long long pre = 0ull;
#pragma unroll 1
            for (int bit = 39; bit >= 0; --bit) {
                const unsigned long long trial = pre | (1ull << bit);
                const int cnt = __popcll(__ballot(k0 >= trial)) + __popcll(__ballot(k1 >= trial));
                if (cnt >= 16) pre = trial;
            }
            if (pre == 0ull) pre = 1ull;
            const unsigned long long mlo = __ballot(k0 >= pre), mhi = __ballot(k1 >= pre);
            if (lane == 0) { selm[qq * 2] = mlo; selm[qq * 2 + 1] = mhi; }
        }
        const unsigned long long mylo = selm[qi * 2], myhi = selm[qi * 2 + 1];
        if (hh == 0 && g4 == 0) { unsigned long long* sp = (unsigned long long*)(ws + WS_SEL) + (row * 4 + g) * 2; sp[0] = mylo; sp[1] = myhi; }
        acc_reset(A);
        const int jlo = t0 >= 511 ? (t0 - 511) >> 6 : 0;
        tile_loop<true>(kwn + (size_t)jlo * 64 * 128, vwn + (size_t)jlo * 64 * 128, 128, cur + 1 - jlo, lds, tid, [&](int i, LAS unsigned char* kl, LAS unsigned char* vl) {
            const int kb = 64 * (jlo + i);
            attn_tile<0>(kl, vl, qf, A, 0.f, kb + 63 <= tq_min && kb >= tq_min + 3 - 511, true, [&](int off) { const int d = tq - (kb + off); return d >= 0 && d < 512; }, NoPF(), lane); });
        bf16_t* op = o1 + row * 2048 + (g * 4 + hh) * 128 + 4 * g4;
        { const float l = A.ls[0]; const float sc = gt2 / l;
#pragma unroll
          for (int n = 0; n < 8; ++n) { f32x4 v = A.o[n] * sc; v[0] += bf_lo(totp[n].x); v[1] += bf_hi(totp[n].x); v[2] += bf_lo(totp[n].y); v[3] += bf_hi(totp[n].y); st_bf4(op + 16 * n, v); } }
    }
}

DI void phase_nsa_slc(const Args& a, LAS unsigned char* lds) {
    unsigned char* ws = a.ws; const int tid0 = threadIdx.x;
    const bf16_t* q1 = (const bf16_t*)(ws + R_Q1); const float* gates = (const float*)(ws + R_GATES); bf16_t* o1 = (bf16_t*)(ws + R_O1);
    for (int it = blockIdx.x; it < 1024; it += gridDim.x) {
        int tid = tid0; asm volatile("" : "+v"(tid));
        const int lane = tid & 63, wid = __builtin_amdgcn_readfirstlane(tid >> 6), r16 = lane & 15, g4 = lane >> 4, qi = r16 >> 2, hh = r16 & 3;
        const int k8 = it >> 7, jr = it & 127, jj = ((jr & 7) << 4) | (jr >> 3), tile = ((it >> 8) & 1) ? 127 - jj : jj, b = k8 >> 2, g = k8 & 3, bg = b * 4 + g;
        const int t0 = tile * 64, cur = tile;
        const bf16_t* ksl = (const bf16_t*)(ws + R_KV + 2 * KVSEC) + (size_t)bg * SEQ * 128; const bf16_t* vsl = (const bf16_t*)(ws + R_KV + 3 * KVSEC) + (size_t)bg * SEQ * 128;
        const int tqa = t0 + wid * 4 + qi, tqb = tqa + 32; const size_t rowa = (size_t)b * SEQ + tqa, rowb = rowa + 32;
        bf16x8 qfa[4], qfb[4]; load_qf(qfa, q1 + rowa * 2048 + (g * 4 + hh) * 128, g4); load_qf(qfb, q1 + rowb * 2048 + (g * 4 + hh) * 128, g4);
        float gta = gates[rowa * 48 + 16 + g * 4 + hh], gtb = gates[rowb * 48 + 16 + g * 4 + hh];
        const unsigned long long* sel = (const unsigned long long*)(ws + WS_SEL);
        unsigned long long alo = sel[(rowa * 4 + g) * 2], ahi = sel[(rowa * 4 + g) * 2 + 1], blo = sel[(rowb * 4 + g) * 2], bhi = sel[(rowb * 4 + g) * 2 + 1];
        asm volatile("" : "+v"(gta), "+v"(gtb), "+v"(alo), "+v"(ahi), "+v"(blo), "+v"(bhi));
        unsigned long long anyalo = alo, anyahi = ahi, anyblo = blo, anybhi = bhi;
        { unsigned long long v;
          v = anyalo; v |= __shfl_xor(v, 4); v |= __shfl_xor(v, 8); anyalo = v;  v = anyahi; v |= __shfl_xor(v, 4); v |= __shfl_xor(v, 8); anyahi = v;
          v = anyblo; v |= __shfl_xor(v, 4); v |= __shfl_xor(v, 8); anyblo = v;  v = anybhi; v |= __shfl_xor(v, 4); v |= __shfl_xor(v, 8); anybhi = v; }
        AttnAcc A, B; acc_reset(A); acc_reset(B);
        tile_loop<true>(ksl, vsl, 128, cur + 1, lds, tid, [&](int j, LAS unsigned char* kl, LAS unsigned char* vl) {
            const int sh = j & 63; const bool hi = j >= 64;
            const bool anya = (((hi ? anyahi : anyalo) >> sh) & 1ull) != 0ull, anyb = (((hi ? anybhi : anyblo) >> sh) & 1ull) != 0ull;
            if (__any(anya)) {
                const bool mine = (((hi ? ahi : alo) >> sh) & 1ull) != 0ull;
                attn_tile<0>(kl, vl, qfa, A, 0.f, j < cur, mine, [&](int off) { return 64 * j + off <= tqa; }, NoPF(), lane);
            }
            if (__any(anyb)) {
                const bool mine = (((hi ? bhi : blo) >> sh) & 1ull) != 0ull;
                attn_tile<0>(kl, vl, qfb, B, 0.f, j < cur, mine, [&](int off) { return 64 * j + off <= tqb; }, NoPF(), lane);
            } });
        { const float l = A.ls[0]; const float sc = gta / l; bf16_t* op = o1 + rowa * 2048 + (g * 4 + hh) * 128 + 4 * g4;
#pragma unroll
          for (int n = 0; n < 8; ++n) { const u32x2 pw = *(const u32x2*)(op + 16 * n); f32x4 v = A.o[n] * sc; v[0] += bf_lo(pw.x); v[1] += bf_hi(pw.x); v[2] += bf_lo(pw.y); v[3] += bf_hi(pw.y); st_bf4(op + 16 * n, v); } }
        { const float l = B.ls[0]; const float sc = gtb / l; bf16_t* op = o1 + rowb * 2048 + (g * 4 + hh) * 128 + 4 * g4;
#pragma unroll
          for (int n = 0; n < 8; ++n) { const u32x2 pw = *(const u32x2*)(op + 16 * n); f32x4 v = B.o[n] * sc; v[0] += bf_lo(pw.x); v[1] += bf_hi(pw.x); v[2] += bf_lo(pw.y); v[3] += bf_hi(pw.y); st_bf4(op + 16 * n, v); } }
    }
}
DI void phase_final(float* h, const float* sumsq, const float* g) {
    int tid_ = threadIdx.x; asm volatile("" : "+v"(tid_)); const size_t gtid = (size_t)blockIdx.x * 512 + tid_, nthr = (size_t)gridDim.x * 512;
    for (size_t i = gtid; i < (size_t)T * 512; i += nthr) { const int row = (int)(i >> 9), c4 = (int)(i & 511) * 4; const float rs = rstd_of(sumsq, row);
        const f32x4 v = *(const f32x4*)(h + i * 4), gg = *(const f32x4*)(g + c4); *(f32x4*)(h + i * 4) = v * rs * gg; }
}
#define XB_TMO      128
#define XB_XCNT(j)  (256  + 64 * (j))
#define XB_XSUB(j)  (1280 + 64 * (j))
#define XB_XGEN(j)  (2304 + 64 * (j))
#define XB_TOP      3328
#define XB_TOPGEN   3392
#define XCD_BAR_WORDS 3456
#define XB_SPIN_CAP (1u << 18)

__device__ __forceinline__ unsigned xb_ld(unsigned* p)              { return __hip_atomic_load(p, __ATOMIC_RELAXED, __HIP_MEMORY_SCOPE_AGENT); }
__device__ __forceinline__ unsigned xb_add(unsigned* p, unsigned v) { return __hip_atomic_fetch_add(p, v, __ATOMIC_RELAXED, __HIP_MEMORY_SCOPE_AGENT); }
__device__ __forceinline__ unsigned xb_xcc_id() { return (unsigned)__builtin_amdgcn_s_getreg((3 << 11) | 20) & 0xFu; }
#define XB_SPIN(cond, bar) do { unsigned _sp = 0; while (cond) { __builtin_amdgcn_s_sleep(1); \
    if ((++_sp & 255u) == 0u) { if (xb_ld(&(bar)[XB_TMO])) break; if (_sp > XB_SPIN_CAP) { atomicAdd(&(bar)[XB_TMO], 1u); break; } } } } while (0)

struct XcdBarrier {
    unsigned* bar; unsigned x;
    volatile LAS unsigned* st;
};

__device__ __forceinline__ XcdBarrier xcd_barrier_post(unsigned* bar, volatile LAS unsigned* st) {
    XcdBarrier b; b.bar = bar; b.x = xb_xcc_id(); b.st = st;
    if (threadIdx.x == 0) (void)xb_add(&bar[XB_XCNT(b.x)], 1u);
    return b;
}
__device__ __forceinline__ void xcd_barrier_complete(unsigned* bar, unsigned x, unsigned& nloc, unsigned& nx) {
    const unsigned G = gridDim.x * gridDim.y * gridDim.z;
    unsigned sum, cnt, mine, sp = 0u;
    for (;;) {
        sum = 0u; cnt = 0u; mine = 0u;
#pragma unroll
        for (unsigned j = 0; j < 16; ++j) { const unsigned c = xb_ld(&bar[XB_XCNT(j)]); sum += c; cnt += (c > 0u) ? 1u : 0u; mine = (j == x) ? c : mine; }
        if (sum == G) break;
        __builtin_amdgcn_s_sleep(1);
        if ((++sp & 255u) == 0u) { if (xb_ld(&bar[XB_TMO])) break; if (sp > XB_SPIN_CAP) { atomicAdd(&bar[XB_TMO], 1u); break; } }
    }
    nloc = mine > 0u ? mine : 1u; nx = cnt > 0u ? cnt : 1u;
}

__device__ __forceinline__ void xcd_barrier(const XcdBarrier& b) {
    asm volatile("s_waitcnt vmcnt(0)" ::: "memory");
    __syncthreads();
    if (threadIdx.x == 0) {
        unsigned* bar = b.bar;
        __builtin_amdgcn_s_waitcnt(0);
        unsigned nloc = b.st[0], nx = b.st[1];
        if (nloc == 0u) { xcd_barrier_complete(bar, b.x, nloc, nx); b.st[0] = nloc; b.st[1] = nx; }
        const unsigned old = xb_add(&bar[XB_XSUB(b.x)], 1u);
        const unsigned gen = old / nloc;
        if (old + 1u == (gen + 1u) * nloc) {
            __builtin_amdgcn_fence(__ATOMIC_RELEASE, "agent");
            asm volatile("s_waitcnt vmcnt(0)" ::: "memory");
            const unsigned og = xb_add(&bar[XB_TOP], 1u);
            const unsigned tg = og / nx;
            if (og + 1u == (tg + 1u) * nx) xb_add(&bar[XB_TOPGEN], 1u);
            else XB_SPIN(xb_ld(&bar[XB_TOPGEN]) == tg, bar);
            __builtin_amdgcn_fence(__ATOMIC_ACQUIRE, "agent");
            xb_add(&bar[XB_XGEN(b.x)], 1u);
            asm volatile("s_waitcnt vmcnt(0)" ::: "memory");
        } else {
            XB_SPIN(xb_ld(&bar[XB_XGEN(b.x)]) == gen, bar);
            __builtin_amdgcn_fence(__ATOMIC_ACQUIRE, "agent");
            asm volatile("s_waitcnt vmcnt(0)" ::: "memory");
        }
    }
    __syncthreads();
}


template <class Epi> DI void run_gemm(LAS unsigned char* lds, const bf16_t* A, const bf16_t* Bt, int M, int N, int K, const Epi& E, int cshift = 0) {
    pg8::Gemm g{A, Bt, M, N, K}; pg8::StaticOrder S; S.init(M, N, (int)gridDim.x, (int)((blockIdx.x + cshift) % gridDim.x)); pg8::gemm_phase(lds, g, S, E);
}
#ifndef PH_LO
#define PH_LO 0
#endif
#ifndef PH_HI
#define PH_HI 17
#endif
__global__ void __launch_bounds__(512, 2) yoco_fwd(Args a) {
    extern __shared__ __attribute__((aligned(16))) unsigned char lds_raw[];
    LAS unsigned char* lds = (LAS unsigned char*)lds_raw;
    cg::grid_group grid = cg::this_grid();
    unsigned char* ws = a.ws;
    float* h = a.out; const float* x = a.in[0];
    bf16_t* HB = (bf16_t*)(ws + WS_HB); bf16_t* HB3 = (bf16_t*)(ws + R_O1); const bf16_t* PB = (const bf16_t*)(ws + WS_PB);
    bf16_t* RB = (bf16_t*)(ws + WS_R); bf16_t* OG = (bf16_t*)(ws + WS_OG); bf16_t* PROJ = OG;
    float* SS = (float*)(ws + WS_SUMSQ); const float* rope = (const float*)(ws + WS_ROPE); float* LSE = (float*)(ws + WS_LSE);
    LAS float* tile = (LAS float*)lds;
    __shared__ uint4 xb_words;
    if (threadIdx.x == 0) xb_words = make_uint4(0u, 0u, 0u, 0u);
    __syncthreads();
    const XcdBarrier xb = xcd_barrier_post((unsigned*)(ws + WS_BAR), (volatile LAS unsigned*)&xb_words);
    phase_prologue(a, lds); grid.sync();
    run_gemm(lds, HB, (const bf16_t*)(ws + WS_W_IN), T, 9216, 2048, EpiQKV0{RB, SS, rope}); xcd_barrier(xb);
    phase_dilated(RB, OG, LSE, lds); xcd_barrier(xb);
    phase_combine(OG, LSE, RB); xcd_barrier(xb);
    run_gemm(lds, RB, (const bf16_t*)(ws + WS_W_OUT), T, 2048, 1024, EpiRes{x, h, HB, SS + T}); xcd_barrier(xb);
    run_gemm(lds, HB, (const bf16_t*)(ws + WS_W_MLP1), T, 8192, 2048, EpiRelu2{RB, SS + T}); xcd_barrier(xb);
    run_gemm(lds, RB, (const bf16_t*)(ws + WS_W_MLP2), T, 2048, 8192, EpiRes{h, h, HB, SS + 2 * T}); xcd_barrier(xb);
    convert_layer1_attn(a, tile); convert_layer_mlp(a, 1, tile);
    run_gemm(lds, PB, (const bf16_t*)(ws + WS_W_PROJ), T, 2048, 256, EpiBf{PROJ, 2048});
    run_gemm(lds, HB, (const bf16_t*)(ws + WS_W_GATE), T, 2048, 2048, EpiGate{h, HB3, PROJ, SS + 2 * T, SS + 3 * T}); xcd_barrier(xb);
    convert_layer_ple(a, 1, tile);
    run_gemm(lds, HB3, (const bf16_t*)(ws + W1_KVQG), T, 5376, 2048, EpiKVQG{(bf16_t*)(ws + R_KV), (bf16_t*)(ws + R_Q1), (float*)(ws + R_GATES), SS + 3 * T, rope}); xcd_barrier(xb);
    run_gemm(lds, (const bf16_t*)(ws + R_KV), (const bf16_t*)(ws + W1_C1K), 4096, 512, 2048, EpiF32{(float*)(ws + R_PQK), 512});
    run_gemm(lds, (const bf16_t*)(ws + R_KV + KVSEC), (const bf16_t*)(ws + W1_C1V), 4096, 512, 2048, EpiF32{(float*)(ws + R_PQV), 512}, (int)gridDim.x - 32); xcd_barrier(xb);
    phase_cmp2(a, lds); xcd_barrier(xb);
    phase_nsa(a, lds); xcd_barrier(xb);
    phase_nsa_slc(a, lds); xcd_barrier(xb);
    run_gemm(lds, (const bf16_t*)(ws + R_O1), (const bf16_t*)(ws + W1_BOUT), T, 2048, 2048, EpiRes{h, h, HB, SS + 4 * T}); xcd_barrier(xb);
    run_gemm(lds, HB, (const bf16_t*)(ws + WS_W_MLP1), T, 8192, 2048, EpiRelu2{RB, SS + 4 * T}); xcd_barrier(xb);
    run_gemm(lds, RB, (const bf16_t*)(ws + WS_W_MLP2), T, 2048, 8192, EpiRes{h, h, HB, SS + 5 * T}); xcd_barrier(xb);
    run_gemm(lds, PB + (size_t)T * 256, (const bf16_t*)(ws + WS_W_PROJ), T, 2048, 256, EpiBf{PROJ, 2048});
    run_gemm(lds, HB, (const bf16_t*)(ws + WS_W_GATE), T, 2048, 2048, EpiGate{h, HB3, PROJ, SS + 5 * T, SS + 6 * T}); xcd_barrier(xb);
    phase_final(h, SS + 6 * T, a.in[21]);
}

extern "C" void kernel_launch(void* const* d_in, const int* in_sizes, int n_in, void* d_out, int out_size, void* d_ws, size_t ws_size, hipStream_t stream) {
    static int grid = 0;
    constexpr int LDS_BYTES = 131072;
    if (grid == 0) {
        if (n_in != 22 || out_size != T * DM || ws_size < WS_END + 16384) { fprintf(stderr, "kernel_launch: unexpected shapes (n_in %d out %d ws %zu need %zu)\n", n_in, out_size, ws_size, (size_t)WS_END); grid = -1; return; }
        int dev = 0, cus = 0, per_cu = 0;
        if (hipGetDevice(&dev) != hipSuccess || hipDeviceGetAttribute(&cus, hipDeviceAttributeMultiprocessorCount, dev) != hipSuccess) { grid = -1; return; }
        if (hipFuncSetAttribute((const void*)yoco_fwd, hipFuncAttributeMaxDynamicSharedMemorySize, LDS_BYTES) != hipSuccess) { fprintf(stderr, "kernel_launch: hipFuncSetAttribute failed\n"); grid = -1; return; }
        if (hipOccupancyMaxActiveBlocksPerMultiprocessor(&per_cu, (const void*)yoco_fwd, 512, LDS_BYTES) != hipSuccess || per_cu < 1) { fprintf(stderr, "kernel_launch: occupancy query says %d\n", per_cu); per_cu = 1; }
        (void)hipGetLastError();
        grid = cus;
    }
    if (grid < 0) return;
    Args a{};
    for (int i = 0; i < 22; ++i) a.in[i] = (const float*)d_in[i];
    a.out = (float*)d_out; a.ws = (unsigned char*)d_ws;
    for (int i = 0; i < 16; ++i) a.inv_freq[i] = (float)std::pow(500000.0, -(double)i * (2.0 / 32.0));
    if (hipMemsetAsync((unsigned char*)d_ws + WS_BAR, 0, XCD_BAR_WORDS * 4, stream) != hipSuccess) { fprintf(stderr, "kernel_launch: memset of the barrier words failed\n"); return; }
    void* args[] = {&a};
    hipError_t e = hipLaunchCooperativeKernel((const void*)yoco_fwd, dim3(grid), dim3(512), args, LDS_BYTES, stream);
    if (e != hipSuccess) fprintf(stderr, "kernel_launch: cooperative launch failed: %s (grid %d)\n", hipGetErrorString(e), grid);
}
```
